# Optimizing an MI355X kernel written in HIP

```python
import jax, jax.numpy as jnp
from jax import lax
import numpy as np

D_MODEL = 2048
BATCH = 4
SEQ = 2048
DEPTH = 1

D_MIX = D_MODEL
D_CONV = D_MIX // 2
D_MLSTM = D_MIX - D_CONV
N_MLSTM_HEADS = 4
DV_HEAD = D_MLSTM // N_MLSTM_HEADS
DQK_HEAD = DV_HEAD // 2
D_QK = N_MLSTM_HEADS * DQK_HEAD
CONV_WIDTH = 3
CHUNK = 64
D_FF = 5632
D_PLE = 256
EPS = 1e-6
D_IN_PROJ = 3 * D_CONV + 2 * D_QK + 2 * D_MLSTM + 2 * N_MLSTM_HEADS

kernel_name = "hymba_style_shortconv_mlstm_convffn_ple"


def rmsnorm(x, g):
    xf = x.astype(jnp.float32)
    y = xf * lax.rsqrt(jnp.mean(xf * xf, axis=-1, keepdims=True) + EPS)
    return (y * g.astype(jnp.float32)).astype(x.dtype)


def causal_dwconv3(u, w):
    S = u.shape[1]
    up = jnp.pad(u, ((0, 0), (CONV_WIDTH - 1, 0), (0, 0)))
    y = up[:, 0:S] * w[0]
    for j in range(1, CONV_WIDTH):
        y = y + up[:, j:j + S] * w[j]
    return y


def mlstm_chunkwise(q, k, v, ig, fg):
    Bn, H, S, dk = q.shape
    dv = v.shape[-1]
    nc = S // CHUNK

    def to_chunks(a):
        a = a.astype(jnp.float32).reshape((Bn, H, nc, CHUNK) + a.shape[3:])
        return jnp.moveaxis(a, 2, 0)

    logf = jax.nn.log_sigmoid(fg.astype(jnp.float32))
    logi = ig.astype(jnp.float32)
    xs = (to_chunks(q), to_chunks(k), to_chunks(v), to_chunks(logf), to_chunks(logi))
    causal = jnp.tril(jnp.ones((CHUNK, CHUNK), dtype=bool))

    def step(carry, xs_c):
        C, n, m = carry
        qb, kb, vb, lf, li = xs_c
        b = jnp.cumsum(lf, axis=-1)
        dlog = b[..., :, None] - b[..., None, :] + li[..., None, :]
        dlog = jnp.where(causal, dlog, -jnp.inf)
        inter = b + m[..., None]
        m_t = jnp.maximum(inter, jnp.max(dlog, axis=-1))
        dw = jnp.exp(dlog - m_t[..., None])
        a_inter = jnp.exp(inter - m_t)
        s = jnp.einsum('bhtd,bhsd->bhts', qb, kb) * dw
        num = (a_inter[..., None] * jnp.einsum('bhvd,bhtd->bhtv', C, qb)
               + jnp.einsum('bhts,bhsv->bhtv', s, vb))
        den = a_inter * jnp.einsum('bhd,bhtd->bht', n, qb) + jnp.sum(s, axis=-1)
        den = jnp.maximum(jnp.abs(den), jnp.exp(-m_t))
        h = num / den[..., None]
        b_tot = b[..., -1]
        wlog = b_tot[..., None] - b + li
        m_new = jnp.maximum(b_tot + m, jnp.max(wlog, axis=-1))
        a_prev = jnp.exp(b_tot + m - m_new)
        w = jnp.exp(wlog - m_new[..., None])
        C_new = a_prev[..., None, None] * C + jnp.einsum('bhs,bhsv,bhsd->bhvd', w, vb, kb)
        n_new = a_prev[..., None] * n + jnp.einsum('bhs,bhsd->bhd', w, kb)
        return (C_new, n_new, m_new), h

    init = (jnp.zeros((Bn, H, dv, dk), jnp.float32),
            jnp.zeros((Bn, H, dk), jnp.float32),
            jnp.zeros((Bn, H), jnp.float32))
    _, hs = lax.scan(step, init, xs)
    return jnp.moveaxis(hs, 0, 2).reshape(Bn, H, S, dv)


def hybrid_mixer(h, w_in, b_igate, b_fgate, short_conv_w, mh_norm_g, w_out):
    Bn, S, _ = h.shape
    proj = h @ w_in
    idx = np.cumsum([D_CONV, D_CONV, D_CONV, D_QK, D_QK, D_MLSTM, D_MLSTM, N_MLSTM_HEADS]).tolist()
    gb, gc, u, q, k, v, o, ig, fg = jnp.split(proj, idx, axis=-1)
    y_conv = gb * causal_dwconv3(gc * u, short_conv_w)
    def heads(a, d):
        return a.reshape(Bn, S, N_MLSTM_HEADS, d).transpose(0, 2, 1, 3)
    qh = heads(q, DQK_HEAD) * (DQK_HEAD ** -0.5)
    kh = heads(k, DQK_HEAD)
    vh = heads(v, DV_HEAD)
    igh = (ig.astype(jnp.float32) + b_igate.astype(jnp.float32)).transpose(0, 2, 1)
    fgh = (fg.astype(jnp.float32) + b_fgate.astype(jnp.float32)).transpose(0, 2, 1)
    hm = mlstm_chunkwise(qh, kh, vh, igh, fgh).transpose(0, 2, 1, 3)
    hm = hm * lax.rsqrt(jnp.mean(hm * hm, axis=-1, keepdims=True) + EPS)
    hm = hm.reshape(Bn, S, D_MLSTM) * mh_norm_g.astype(jnp.float32)
    y_m = (jax.nn.sigmoid(o.astype(jnp.float32)) * hm).astype(h.dtype)
    return jnp.concatenate([y_conv, y_m], axis=-1) @ w_out


def conv_ffn(h, w_up, ffn_conv_w, ffn_conv_b, w_down):
    up = causal_dwconv3(h @ w_up, ffn_conv_w) + ffn_conv_b
    g, u = jnp.split(up, 2, axis=-1)
    return (jax.nn.silu(g) * u) @ w_down


def setup_inputs(seed: int = 0) -> dict:
    key = jax.random.key(seed)
    ks = jax.random.split(key, 20)
    f32 = jnp.float32
    nrm = lambda k, shape, s: jax.random.normal(k, shape, f32) * s
    H = N_MLSTM_HEADS
    return {
        "x": nrm(ks[0], (BATCH, SEQ, D_MODEL), 1.0),
        "p": nrm(ks[1], (DEPTH, BATCH, SEQ, D_PLE), 1.0),
        "norm_mix_g": 1.0 + nrm(ks[2], (DEPTH, D_MODEL), 0.1),
        "w_in": nrm(ks[3], (DEPTH, D_MODEL, D_IN_PROJ), D_MODEL ** -0.5),
        "b_igate": nrm(ks[4], (DEPTH, H), 0.1) - 1.0,
        "b_fgate": nrm(ks[5], (DEPTH, H), 0.5) + 3.0,
        "short_conv_w": nrm(ks[6], (DEPTH, CONV_WIDTH, D_CONV), CONV_WIDTH ** -0.5),
        "mh_norm_g": 1.0 + nrm(ks[7], (DEPTH, D_MLSTM), 0.1),
        "w_out": nrm(ks[8], (DEPTH, D_MIX, D_MODEL), D_MIX ** -0.5),
        "norm_ffn_g": 1.0 + nrm(ks[9], (DEPTH, D_MODEL), 0.1),
        "w_up": nrm(ks[10], (DEPTH, D_MODEL, 2 * D_FF), D_MODEL ** -0.5),
        "ffn_conv_w": nrm(ks[11], (DEPTH, CONV_WIDTH, 2 * D_FF), CONV_WIDTH ** -0.5),
        "ffn_conv_b": nrm(ks[12], (DEPTH, 2 * D_FF), 0.01),
        "w_down": nrm(ks[13], (DEPTH, D_FF, D_MODEL), D_FF ** -0.5),
        "norm_ple_g": 1.0 + nrm(ks[14], (DEPTH, D_MODEL), 0.1),
        "w_ple_gate": nrm(ks[15], (DEPTH, D_MODEL, D_MODEL), D_MODEL ** -0.5),
        "w_ple_proj": nrm(ks[16], (DEPTH, D_PLE, D_MODEL), D_PLE ** -0.5),
        "final_norm_g": 1.0 + nrm(ks[17], (D_MODEL,), 0.1),
    }


def reference(x, p, norm_mix_g, w_in, b_igate, b_fgate, short_conv_w, mh_norm_g, w_out,
              norm_ffn_g, w_up, ffn_conv_w, ffn_conv_b, w_down, norm_ple_g, w_ple_gate,
              w_ple_proj, final_norm_g):
    for i in range(DEPTH):
        h = rmsnorm(x, norm_mix_g[i])
        x = x + hybrid_mixer(h, w_in[i], b_igate[i], b_fgate[i], short_conv_w[i],
                             mh_norm_g[i], w_out[i])
        h = rmsnorm(x, norm_ffn_g[i])
        x = x + conv_ffn(h, w_up[i], ffn_conv_w[i], ffn_conv_b[i], w_down[i])
        h = rmsnorm(x, norm_ple_g[i])
        gate = jax.nn.sigmoid((h @ w_ple_gate[i]).astype(jnp.float32)).astype(x.dtype)
        x = x + gate * (p[i] @ w_ple_proj[i])
    return rmsnorm(x, final_norm_g)
```

```cpp
#include <hip/hip_runtime.h>
#include <hip/hip_cooperative_groups.h>
#include <cstdio>
namespace cg = cooperative_groups;
#ifndef N_LAUNCH_MODE
#define N_LAUNCH_MODE 1
#endif
__device__ __forceinline__ int lane_id() { return (int)__builtin_amdgcn_mbcnt_hi(~0u, __builtin_amdgcn_mbcnt_lo(~0u, 0u)); }
#define TID_X (wv * 64 + lane_id())
namespace pg8 {
#define PG8_LAS __attribute__((address_space(3)))
typedef unsigned short bf16_t;
typedef short bf16x8 __attribute__((ext_vector_type(8)));
typedef float f32x4 __attribute__((ext_vector_type(4)));
typedef unsigned u32x4 __attribute__((ext_vector_type(4)));
constexpr int BM = 256, BK = 64, HALF = 128, HTB = HALF * BK * 2  , STAGE_BYTES = 8 * HTB, NXCD = 8, WGM = 8;

__host__ __device__ __forceinline__ int lds_byte(int r, int c) { const int st = (r >> 4) * 2 + (c >> 5), rr = r & 15, cc = c & 31, ob = rr * 64 + cc * 2; return st * 1024 + (ob ^ (((ob >> 9) & 1) << 5)); }
__host__ __device__ __forceinline__ void stage_rc(int b, int& R, int& C) { const int st = b / 1024, sb = b % 1024, swz = sb ^ (((sb >> 9) & 1) << 5); R = (st >> 1) * 16 + swz / 64; C = (st & 1) * 32 + (swz % 64) / 2; }
__host__ __device__ __forceinline__ int perm32(int rho) { const int n = rho >> 4, i = rho & 15; return 8 * (i >> 2) + 4 * n + (i & 3); }

struct Unit { int pm, pn; };
struct Gemm { const bf16_t* A; const bf16_t* Bt; int M, N, K; };

struct StaticOrder {
    int nM, nN, nwg, G, c;
    __host__ __device__ void init(int M, int N, int G_, int c_) { nM = M / BM; nN = N / BM; nwg = nM * nN; G = G_; c = c_; }
    __host__ __device__ bool next(int i, Unit& u) const {
        const long L = (long)i * G + c; if (L >= nwg) return false;
        int wgid = (int)L; { const int q = nwg / NXCD, r = nwg % NXCD, xcd = wgid % NXCD, off = wgid / NXCD; wgid = (xcd < r ? xcd * (q + 1) : r * (q + 1) + (xcd - r) * q) + off; }
        const int nig = WGM * nN, gid = wgid / nig, fm = gid * WGM, gsz = (nM - fm) < WGM ? (nM - fm) : WGM;
        u.pm = fm + ((wgid % nig) % gsz); u.pn = (wgid % nig) / gsz; return true;
    }
    __device__ __forceinline__ void a_ready(const Unit&) const {}
    __device__ __forceinline__ void done(const Unit&) const {}
};
template <class Epi, class Sched>
__device__ __forceinline__ void gemm_phase(PG8_LAS unsigned char* lds, const Gemm g, const Sched& S, const Epi& E, const int wv) {
    const int wid = wv, lane = lane_id(), tid = wv * 64 + lane, wr = wid >> 2, wc = wid & 3, fr = lane & 15, fq = lane >> 4;
    const int K = g.K, nt = K / BK;
    unsigned voffA[2], voffB[2];
#pragma unroll
    for (int i = 0; i < 2; ++i) { int R, C; stage_rc(tid * 16 + i * 8192, R, C); const int Rb = Epi::PERM ? ((R & ~31) + perm32(R & 31)) : R;
        voffA[i] = (unsigned)(R * K + C) * 2u; voffB[i] = (unsigned)(Rb * K + C) * 2u; }
    const size_t kstep = (size_t)(BK * 2);
    const size_t hstep = (size_t)HALF * K * 2;
    const size_t tstep = 2 * hstep;
    const unsigned ldsw = (unsigned)wid * 1024u;
    const int aoff = lds_byte(wr * 64 + fr, fq * 8), boff = lds_byte(wc * 32 + fr, fq * 8);
#define PG8_SA(b, h) (((b) * 2 + (h)) * HTB)
#define PG8_SB(b, h) ((4 + (b) * 2 + (h)) * HTB)
#define PG8_STAGE(bufoff, gbase, voff) do { _Pragma("unroll") for (int _i = 0; _i < 2; ++_i) \
        __builtin_amdgcn_global_load_lds((const unsigned*)((const char*)(gbase) + (voff)[_i]), (PG8_LAS unsigned*)(lds + (bufoff) + ldsw + _i * 8192), 16, 0, 0); } while (0)
#define PG8_LDA(dst, b, h) do { _Pragma("unroll") for (int m = 0; m < 4; ++m) _Pragma("unroll") for (int k = 0; k < 2; ++k) dst[m][k] = *(const PG8_LAS bf16x8*)(lds + PG8_SA(b, h) + aoff + m * 2048 + k * 1024); } while (0)
#define PG8_LDB(dst, b, h) do { _Pragma("unroll") for (int n = 0; n < 2; ++n) _Pragma("unroll") for (int k = 0; k < 2; ++k) dst[n][k] = *(const PG8_LAS bf16x8*)(lds + PG8_SB(b, h) + boff + n * 2048 + k * 1024); } while (0)
#define PG8_MMA(ai, bj, At, Bt) do { __builtin_amdgcn_s_setprio(1); _Pragma("unroll") for (int m = 0; m < 4; ++m) _Pragma("unroll") for (int n = 0; n < 2; ++n) _Pragma("unroll") for (int k = 0; k < 2; ++k) \
        acc[ai][bj][m][n] = __builtin_amdgcn_mfma_f32_16x16x32_bf16(Bt[n][k], At[m][k], acc[ai][bj][m][n], 0, 0, 0); __builtin_amdgcn_s_setprio(0); } while (0)
#define PG8_WAIT_V(n) asm volatile("s_waitcnt vmcnt(" #n ")" ::: "memory")
#define PG8_WAIT_L(n) asm volatile("s_waitcnt lgkmcnt(" #n ")" ::: "memory")
#define PG8_BAR __builtin_amdgcn_s_barrier()
#define PG8_SCHED __builtin_amdgcn_sched_barrier(0)
    Unit cur, nxt; int ui = 0;
    if (!S.next(0, cur)) return;
    f32x4 acc[2][2][4][2];
#pragma unroll
    for (int a = 0; a < 2; ++a)
#pragma unroll
        for (int b = 0; b < 2; ++b)
#pragma unroll
            for (int m = 0; m < 4; ++m)
#pragma unroll
                for (int n = 0; n < 2; ++n) acc[a][b][m][n] = (f32x4){0.f, 0.f, 0.f, 0.f};
    bf16x8 At[4][2], B0[2][2], B1[2][2];
    const char* cA = (const char*)g.A + (size_t)cur.pm * tstep; const char* cB = (const char*)g.Bt + (size_t)cur.pn * tstep;
    S.a_ready(cur);
    PG8_STAGE(PG8_SB(0, 0), cB, voffB); PG8_STAGE(PG8_SA(0, 0), cA, voffA); PG8_STAGE(PG8_SB(0, 1), cB + hstep, voffB); PG8_STAGE(PG8_SA(0, 1), cA + hstep, voffA);
    if (wr == 1) PG8_BAR;
    PG8_WAIT_V(4); PG8_BAR;
    PG8_STAGE(PG8_SB(1, 0), cB + kstep, voffB); PG8_STAGE(PG8_SA(1, 0), cA + kstep, voffA); PG8_STAGE(PG8_SB(1, 1), cB + hstep + kstep, voffB);
    PG8_WAIT_V(6); PG8_BAR;
    for (;;) {
        const bool has_next = S.next(ui + 1, nxt);
        const char* nA = has_next ? (const char*)g.A + (size_t)nxt.pm * tstep : cA; const char* nB = has_next ? (const char*)g.Bt + (size_t)nxt.pn * tstep : cB;
        for (int t = 0; t < nt; t += 2) {
            const bool last = (t == nt - 2);
            const char* a1 = cA + (size_t)(t + 1) * kstep;
            const char* a2 = last ? nA : cA + (size_t)(t + 2) * kstep; const char* b2 = last ? nB : cB + (size_t)(t + 2) * kstep;
            const char* a3 = a2 + kstep; const char* b3 = b2 + kstep;
            if (last && has_next) S.a_ready(nxt);
            PG8_LDB(B0, 0, 0); PG8_SCHED; PG8_LDA(At, 0, 0); PG8_STAGE(PG8_SA(1, 1), a1 + hstep, voffA);
            PG8_WAIT_L(8); PG8_BAR; PG8_WAIT_L(0); PG8_MMA(0, 0, At, B0); PG8_BAR; PG8_SCHED;
            PG8_LDB(B1, 0, 1); PG8_STAGE(PG8_SB(0, 0), b2, voffB);
            PG8_BAR; PG8_WAIT_L(0); PG8_MMA(0, 1, At, B1); PG8_BAR;
            PG8_LDA(At, 0, 1); PG8_STAGE(PG8_SA(0, 0), a2, voffA);
            PG8_BAR; PG8_WAIT_L(0); PG8_MMA(1, 0, At, B0); PG8_BAR; PG8_SCHED;
            PG8_STAGE(PG8_SB(0, 1), b2 + hstep, voffB);
            PG8_WAIT_V(6); PG8_BAR; PG8_MMA(1, 1, At, B1); PG8_BAR;
            PG8_LDB(B0, 1, 0); PG8_SCHED; PG8_LDA(At, 1, 0); PG8_STAGE(PG8_SA(0, 1), a2 + hstep, voffA);
            PG8_WAIT_L(8); PG8_BAR; PG8_WAIT_L(0); PG8_MMA(0, 0, At, B0); PG8_BAR; PG8_SCHED;
            PG8_LDB(B1, 1, 1); PG8_STAGE(PG8_SB(1, 0), b3, voffB);
            PG8_BAR; PG8_WAIT_L(0); PG8_MMA(0, 1, At, B1); PG8_BAR;
            PG8_LDA(At, 1, 1); PG8_STAGE(PG8_SA(1, 0), a3, voffA);
            PG8_BAR; PG8_WAIT_L(0); PG8_MMA(1, 0, At, B0); PG8_BAR; PG8_SCHED;
            PG8_STAGE(PG8_SB(1, 1), b3 + hstep, voffB);
            PG8_WAIT_V(6); PG8_BAR; PG8_MMA(1, 1, At, B1); PG8_BAR;
        }
        if constexpr (!Epi::AFTER_DRAIN) { E(acc, cur, wr, wc, fr, fq); S.done(cur); }
        if (!has_next) break;
#pragma unroll
        for (int a = 0; a < 2; ++a)
#pragma unroll
            for (int b = 0; b < 2; ++b)
#pragma unroll
                for (int m = 0; m < 4; ++m)
#pragma unroll
                    for (int n = 0; n < 2; ++n) acc[a][b][m][n] = (f32x4){0.f, 0.f, 0.f, 0.f};
        cur = nxt; cA = nA; cB = nB; ++ui;
    }
    PG8_WAIT_V(0);
    if (wr == 0) PG8_BAR;
    PG8_BAR;
    if constexpr (Epi::AFTER_DRAIN) { E.fused(acc, cur, wr, wc, fr, fq, lds, wid, lane); S.done(cur); }
#undef PG8_SA
#undef PG8_SB
#undef PG8_STAGE
#undef PG8_LDA
#undef PG8_LDB
#undef PG8_MMA
#undef PG8_WAIT_V
#undef PG8_WAIT_L
#undef PG8_BAR
#undef PG8_SCHED
}
}
using pg8::bf16_t; using pg8::bf16x8; using pg8::f32x4; using pg8::u32x4; using pg8::Unit;
#define LAS __attribute__((address_space(3)))
typedef unsigned u32x2 __attribute__((ext_vector_type(2)));

constexpr int T_ = 8192, D_ = 2048, NP_ = 6144, NPF_ = 6152, DFF_ = 5632, NUP_ = 11264, DPLE_ = 256, SEQ_ = 2048;
constexpr float EPS_ = 1e-6f;
constexpr size_t MiB = (size_t)1 << 20;
constexpr size_t WS_SMALL = 0, WS_WPG = 3 * MiB, WS_WDOWN = 11 * MiB, WS_PP = 33 * MiB,
                 WS_PROJ = 65 * MiB, WS_WOUT = 161 * MiB, WS_WPP = 169 * MiB, WS_PB = 170 * MiB,
                 WS_UP = 65 * MiB, WS_X2B = 65 * MiB, WS_WUP = 241 * MiB, WS_X1B = 285 * MiB, WS_WIN = 285 * MiB,
                 WS_XB = 317 * MiB, WS_Y = 285 * MiB, WS_ACT = 241 * MiB, WS_X3B = 65 * MiB, WS_X2B2 = 100 * MiB, WS_END = 349 * MiB;
constexpr size_t OUT_PB = (size_t)T_ * D_, OUT_WPP = (size_t)T_ * D_ + (size_t)T_ * DPLE_;
constexpr size_t SM_RSTD0 = 0, SM_GATES = 64 * 1024, SM_ACUM = 320 * 1024, SM_MRUN = 448 * 1024, SM_BCUM = 576 * 1024, SM_CNT = 704 * 1024, SM_BAR = 960 * 1024, SM_SSA = 1 * MiB, SM_SSB = 2 * MiB;
constexpr int LDS_BYTES = 131072 + 1024;

struct Params { const float* in[18]; float* out; unsigned char* ws; int ph_lo, ph_hi; };

__device__ __forceinline__ unsigned pk_bf16(float lo, float hi) { unsigned r; asm("v_cvt_pk_bf16_f32 %0, %1, %2" : "=v"(r) : "v"(lo), "v"(hi)); return r; }
__device__ __forceinline__ float bflo(unsigned w) { return __uint_as_float(w << 16); }
__device__ __forceinline__ float bfhi(unsigned w) { return __uint_as_float(w & 0xffff0000u); }
__device__ __forceinline__ float sigm(float x) { return __builtin_amdgcn_rcpf(1.0f + __expf(-x)); }
__device__ __forceinline__ float wave_sum(float v) {
#pragma unroll
    for (int o = 32; o; o >>= 1) v += __shfl_xor(v, o);
    return v;
}
__device__ __forceinline__ void unpack8(const u32x4 w, float (&f)[8]) {
    f[0] = bflo(w.x); f[1] = bfhi(w.x); f[2] = bflo(w.y); f[3] = bfhi(w.y); f[4] = bflo(w.z); f[5] = bfhi(w.z); f[6] = bflo(w.w); f[7] = bfhi(w.w);
}
__device__ __forceinline__ u32x4 pack8(const float (&f)[8]) { u32x4 w; w.x = pk_bf16(f[0], f[1]); w.y = pk_bf16(f[2], f[3]); w.z = pk_bf16(f[4], f[5]); w.w = pk_bf16(f[6], f[7]); return w; }

struct TileDesc { const float* src; bf16_t* dst; const float* gk; int N, ldt, k0, n0; float cs; };
__device__ __forceinline__ TileDesc tile_desc(const Params& p, int l) {
    constexpr int NT_IN = 32 * 96, NT_PP = 4 * 32, NT_OUT = 32 * 32, NT_UP = 32 * 176, NT_DOWN = 88 * 32;
    unsigned char* ws = p.ws; TileDesc d; d.cs = 1.0f; d.gk = nullptr; int ntn;
    if (l < NT_IN) { ntn = 96; d.src = p.in[3]; d.N = NPF_; d.dst = (bf16_t*)(ws + WS_WIN); d.ldt = D_; d.gk = p.in[2]; const int nt = l % 96; if (nt >= 48 && nt < 56) d.cs = 0.08838834764831845f; }
    else if ((l -= NT_IN) < NT_PP) { ntn = 32; d.src = p.in[16]; d.N = D_; d.dst = (bf16_t*)p.out + OUT_WPP; d.ldt = DPLE_; }
    else if ((l -= NT_PP) < NT_OUT) { ntn = 32; d.src = p.in[8]; d.N = D_; d.dst = (bf16_t*)(ws + WS_WOUT); d.ldt = D_; }
    else if ((l -= NT_OUT) < NT_UP) { ntn = 176; d.src = p.in[10]; d.N = NUP_; d.dst = (bf16_t*)(ws + WS_WUP); d.ldt = D_; d.gk = p.in[9]; }
    else if ((l -= NT_UP) < NT_DOWN) { ntn = 32; d.src = p.in[13]; d.N = D_; d.dst = (bf16_t*)(ws + WS_WDOWN); d.ldt = DFF_; }
    else { l -= NT_DOWN; ntn = 32; d.src = p.in[15]; d.N = D_; d.dst = (bf16_t*)(ws + WS_WPG); d.ldt = D_; d.gk = p.in[14]; }
    d.n0 = (l % ntn) * 64; d.k0 = (l / ntn) * 64; return d;
}

constexpr int NT_EARLY = 32 * 96 + 4 * 32 + 32 * 32 + 32 * 176;
constexpr int NT_ALL = NT_EARLY + 88 * 32 + 32 * 32;
__device__ void convert_tiles(const Params& p, LAS unsigned char* lds, const int first, const int last, const int worker, const int nworkers, const int wv) {
    const int tid = TID_X;
    const int n4 = tid & 15, kp = tid >> 4, r = tid >> 3, c = tid & 7;
    for (int i4 = first + worker * 4; i4 < last; i4 += nworkers * 4) {
        f32x4 a[4], b[4]; float g0[4], g1[4];
#pragma unroll
        for (int u = 0; u < 4; ++u) {
            const TileDesc d = tile_desc(p, i4 + u);
            const float* src = d.src + (size_t)(d.k0 + 2 * kp) * d.N + d.n0 + 4 * n4;
            a[u] = __builtin_nontemporal_load((const f32x4*)src); b[u] = __builtin_nontemporal_load((const f32x4*)(src + d.N));
            g0[u] = d.cs; g1[u] = d.cs;
            if (d.gk) { g0[u] *= d.gk[d.k0 + 2 * kp]; g1[u] *= d.gk[d.k0 + 2 * kp + 1]; }
        }
        __syncthreads();
#pragma unroll
        for (int u = 0; u < 4; ++u) {
            LAS unsigned* l32 = (LAS unsigned*)(lds + u * 8448);
#pragma unroll
            for (int j = 0; j < 4; ++j) l32[(4 * n4 + j) * 33 + kp] = pk_bf16(a[u][j] * g0[u], b[u][j] * g1[u]);
        }
        __syncthreads();
#pragma unroll
        for (int u = 0; u < 4; ++u) {
            const TileDesc d = tile_desc(p, i4 + u);
            LAS unsigned* l32 = (LAS unsigned*)(lds + u * 8448);
            u32x4 o; o.x = l32[r * 33 + 4 * c]; o.y = l32[r * 33 + 4 * c + 1]; o.z = l32[r * 33 + 4 * c + 2]; o.w = l32[r * 33 + 4 * c + 3];
            *(u32x4*)(d.dst + (size_t)(d.n0 + r) * d.ldt + d.k0 + 8 * c) = o;
        }
    }
}

__device__ void phase_prep(const Params& p, LAS unsigned char* lds, const int wv) {
    const int wid = wv, lane = lane_id(), tid = wv * 64 + lane;
    unsigned char* ws = p.ws;
    convert_tiles(p, lds, 0, NT_EARLY, blockIdx.x, gridDim.x, wv);
    __syncthreads();
    LAS float* wg = (LAS float*)(lds + 32768);
    for (int i = tid; i < 2048 * 2; i += 512) {
        const int k = i >> 1, hf = i & 1;
        f32x4 v = *(const f32x4*)(p.in[3] + (size_t)k * NPF_ + NP_ + 4 * hf);
        const float g = p.in[2][k];
#pragma unroll
        for (int j = 0; j < 4; ++j) wg[(4 * hf + j) * 2048 + k] = v[j] * g;
    }
    __syncthreads();
    bf16_t* xb = (bf16_t*)(ws + WS_XB);
    float* rstd0 = (float*)(ws + WS_SMALL + SM_RSTD0);
    float* gates = (float*)(ws + WS_SMALL + SM_GATES);
    for (int row = blockIdx.x * 8 + wid; row < T_; row += gridDim.x * 8) {
        const float* xr = p.in[0] + (size_t)row * D_;
        float ss = 0.f, dots[8];
#pragma unroll
        for (int j = 0; j < 8; ++j) dots[j] = 0.f;
#pragma unroll
        for (int i = 0; i < 8; ++i) {
            const int k = (i * 64 + lane) * 4;
            const f32x4 v = __builtin_nontemporal_load((const f32x4*)(xr + k));
            ss += v.x * v.x + v.y * v.y + v.z * v.z + v.w * v.w;
            u32x2 o; o.x = pk_bf16(v.x, v.y); o.y = pk_bf16(v.z, v.w);
            *(u32x2*)(xb + (size_t)row * D_ + k) = o;
#pragma unroll
            for (int j = 0; j < 8; ++j) { const f32x4 w = *(const LAS f32x4*)(wg + j * 2048 + k); dots[j] += v.x * w.x + v.y * w.y + v.z * w.z + v.w * w.w; }
        }
        ss = wave_sum(ss);
#pragma unroll
        for (int j = 0; j < 8; ++j) dots[j] = wave_sum(dots[j]);
        const float rs = rsqrtf(ss * (1.0f / D_) + EPS_);
        if (lane == 0) rstd0[row] = rs;
        if (lane < 8) {
            float d = dots[0];
#pragma unroll
            for (int j = 1; j < 8; ++j) d = (lane == j) ? dots[j] : d;
            const float bias = (lane < 4) ? p.in[4][lane & 3] : p.in[5][lane & 3];
            gates[(size_t)row * 8 + lane] = rs * d + bias;
        }
    }
    {
        bf16_t* pb = (bf16_t*)p.out + OUT_PB;
        const size_t n4 = (size_t)T_ * DPLE_ / 4;
        for (size_t i = (size_t)blockIdx.x * 512 + tid; i < n4; i += (size_t)gridDim.x * 512) {
            const f32x4 v = __builtin_nontemporal_load((const f32x4*)(p.in[1] + i * 4));
            u32x2 o; o.x = pk_bf16(v.x, v.y); o.y = pk_bf16(v.z, v.w);
            *(u32x2*)(pb + i * 4) = o;
        }
    }
}

#define DPPF(old, x, ctrl, rmask) __builtin_bit_cast(float, __builtin_amdgcn_update_dpp(__builtin_bit_cast(int, (float)(old)), __builtin_bit_cast(int, (float)(x)), ctrl, rmask, 0xf, false))
__device__ __forceinline__ float wave_scan_add(float v) {
    v += DPPF(0.f, v, 0x111, 0xf); v += DPPF(0.f, v, 0x112, 0xf); v += DPPF(0.f, v, 0x114, 0xf); v += DPPF(0.f, v, 0x118, 0xf);
    v += DPPF(0.f, v, 0x142, 0xa); v += DPPF(0.f, v, 0x143, 0xc);
    return v;
}
__device__ __forceinline__ float wave_scan_max(float v) {
    const float ninf = -__builtin_inff();
    v = fmaxf(v, DPPF(ninf, v, 0x111, 0xf)); v = fmaxf(v, DPPF(ninf, v, 0x112, 0xf)); v = fmaxf(v, DPPF(ninf, v, 0x114, 0xf)); v = fmaxf(v, DPPF(ninf, v, 0x118, 0xf));
    v = fmaxf(v, DPPF(ninf, v, 0x142, 0xa)); v = fmaxf(v, DPPF(ninf, v, 0x143, 0xc));
    return v;
}
__device__ void scan_gates(const float* gates, float* acum, float* mrun, float* bcum, int bh, int lane) {
    const int batch = bh >> 2, h = bh & 3;
    float fgv[32], igv[32];
#pragma unroll
    for (int r = 0; r < 32; ++r) { const size_t t = (size_t)batch * SEQ_ + r * 64 + lane; fgv[r] = gates[t * 8 + 4 + h]; igv[r] = gates[t * 8 + h]; }
    float carryB = 0.f, carryM = 0.f;
#pragma unroll
    for (int r = 0; r < 32; ++r) {
        const int s = r * 64 + lane;
        const float fg = fgv[r], ig = igv[r];
        const float lf = -(fmaxf(-fg, 0.f) + log1pf(expf(-fabsf(fg))));
        const float B = carryB + wave_scan_add(lf);
        const float a = ig - B;
        const float M = fmaxf(carryM, wave_scan_max(a));
        acum[bh * SEQ_ + s] = a; mrun[bh * SEQ_ + s] = M; bcum[bh * SEQ_ + s] = B;
        carryB = __builtin_bit_cast(float, __builtin_amdgcn_readlane(__builtin_bit_cast(int, B), 63));
        carryM = __builtin_bit_cast(float, __builtin_amdgcn_readlane(__builtin_bit_cast(int, M), 63));
    }
}

#define SCHED_FENCE() __builtin_amdgcn_sched_barrier(0)
__device__ __forceinline__ void store_bf16_rows(const f32x4 (&acc)[2][2][4][2], bf16_t* O, int ldc, int row0, int col0, const float (&rs)[2][4]) {
#pragma unroll
    for (int ai = 0; ai < 2; ++ai)
#pragma unroll
        for (int m = 0; m < 4; ++m) {
            bf16_t* rowp = O + (size_t)(row0 + ai * 128 + m * 16) * ldc + col0;
            const float r = rs[ai][m];
#pragma unroll
            for (int bj = 0; bj < 2; ++bj) {
                const f32x4 v0 = acc[ai][bj][m][0] * r, v1 = acc[ai][bj][m][1] * r;
                u32x4 w; w.x = pk_bf16(v0[0], v0[1]); w.y = pk_bf16(v0[2], v0[3]); w.z = pk_bf16(v1[0], v1[1]); w.w = pk_bf16(v1[2], v1[3]);
                *(u32x4*)(rowp + bj * 128) = w;
            }
        }
}
struct EpiBf16Scale {
    static constexpr bool PERM = true, AFTER_DRAIN = false;
    bf16_t* O; int ldc; const float* rowscale;
    __device__ __forceinline__ void operator()(const f32x4 (&acc)[2][2][4][2], const Unit& u, int wr, int wc, int fr, int fq) const {
        const int row0 = u.pm * 256 + wr * 64 + fr, col0 = u.pn * 256 + wc * 32 + 8 * fq;
        float rs[2][4];
#pragma unroll
        for (int ai = 0; ai < 2; ++ai)
#pragma unroll
            for (int m = 0; m < 4; ++m) rs[ai][m] = rowscale ? rowscale[row0 + ai * 128 + m * 16] : 1.0f;
        SCHED_FENCE();
        store_bf16_rows(acc, O, ldc, row0, col0, rs);
    }
};
__device__ __forceinline__ void rstd_rows(const float* ss, int row0, int fq, float (&rs)[2][4]) {
    f32x4 a[2][4], b[2][4];
#pragma unroll
    for (int ai = 0; ai < 2; ++ai)
#pragma unroll
        for (int m = 0; m < 4; ++m) { const float* q = ss + (size_t)(row0 + ai * 128 + m * 16) * 32 + 8 * fq; a[ai][m] = *(const f32x4*)q; b[ai][m] = *(const f32x4*)(q + 4); }
    SCHED_FENCE();
#pragma unroll
    for (int ai = 0; ai < 2; ++ai)
#pragma unroll
        for (int m = 0; m < 4; ++m) {
            const f32x4 x = a[ai][m], y = b[ai][m];
            float t = ((x.x + x.y) + (x.z + x.w)) + ((y.x + y.y) + (y.z + y.w));
            t += __shfl_xor(t, 16); t += __shfl_xor(t, 32);
            rs[ai][m] = rsqrtf(t * (1.0f / D_) + EPS_);
        }
}
struct EpiBf16Norm {
    static constexpr bool PERM = true, AFTER_DRAIN = false;
    bf16_t* O; int ldc; const float* ss;
    __device__ __forceinline__ void operator()(const f32x4 (&acc)[2][2][4][2], const Unit& u, int wr, int wc, int fr, int fq) const {
        const int row0 = u.pm * 256 + wr * 64 + fr, col0 = u.pn * 256 + wc * 32 + 8 * fq;
        float rs[2][4];
        rstd_rows(ss, row0, fq, rs);
        SCHED_FENCE();
        store_bf16_rows(acc, O, ldc, row0, col0, rs);
    }
};
struct EpiResidBf {
    static constexpr bool PERM = true, AFTER_DRAIN = false;
    const bf16_t* base; bf16_t* ob; float* ssout;
    __device__ __forceinline__ void operator()(const f32x4 (&acc)[2][2][4][2], const Unit& u, int wr, int wc, int fr, int fq) const {
        const int row0 = u.pm * 256 + wr * 64 + fr, col0 = u.pn * 256 + wc * 32 + 8 * fq;
        u32x4 r[4][2];
#define ER_LOAD(q) do { const size_t off_ = (size_t)(row0 + ((q) >> 2) * 128 + ((q) & 3) * 16) * D_ + col0; r[(q) & 3][0] = *(const u32x4*)(base + off_); r[(q) & 3][1] = *(const u32x4*)(base + off_ + 128); } while (0)
        ER_LOAD(0); ER_LOAD(1); ER_LOAD(2);
#pragma unroll
        for (int q = 0; q < 8; ++q) {
            const int ai = q >> 2, m = q & 3;
            if (q + 3 < 8) ER_LOAD(q + 3);
            SCHED_FENCE();
            const int row = row0 + ai * 128 + m * 16;
            const size_t off = (size_t)row * D_ + col0;
            float s = 0.f;
#pragma unroll
            for (int bj = 0; bj < 2; ++bj) {
                float f[8]; unpack8(r[q & 3][bj], f);
                const f32x4 v0 = acc[ai][bj][m][0] + (f32x4){f[0], f[1], f[2], f[3]}, v1 = acc[ai][bj][m][1] + (f32x4){f[4], f[5], f[6], f[7]};
                u32x4 w; w.x = pk_bf16(v0[0], v0[1]); w.y = pk_bf16(v0[2], v0[3]); w.z = pk_bf16(v1[0], v1[1]); w.w = pk_bf16(v1[2], v1[3]);
                *(u32x4*)(ob + off + bj * 128) = w;
                s += (v0[0] * v0[0] + v0[1] * v0[1]) + (v0[2] * v0[2] + v0[3] * v0[3]) + (v1[0] * v1[0] + v1[1] * v1[1]) + (v1[2] * v1[2] + v1[3] * v1[3]);
            }
            s += __shfl_xor(s, 16); s += __shfl_xor(s, 32);
            if (fq == 0) ssout[(size_t)row * 32 + u.pn * 4 + wc] = s;
            SCHED_FENCE();
        }
#undef ER_LOAD
    }
};
struct EpiPleGateBf {
    static constexpr bool PERM = true, AFTER_DRAIN = false;
    const bf16_t* base; bf16_t* ob; const bf16_t* pp; const float* ssin; float* ssout;
    __device__ __forceinline__ void operator()(const f32x4 (&acc)[2][2][4][2], const Unit& u, int wr, int wc, int fr, int fq) const {
        const int row0 = u.pm * 256 + wr * 64 + fr, col0 = u.pn * 256 + wc * 32 + 8 * fq;
        float rs[2][4];
        rstd_rows(ssin, row0, fq, rs);
        u32x4 r[2][2], pw[2][2];
#define EP_LOAD(slot, q) do { const size_t off_ = (size_t)(row0 + ((q) >> 2) * 128 + ((q) & 3) * 16) * D_ + col0; \
            r[slot][0] = *(const u32x4*)(base + off_); r[slot][1] = *(const u32x4*)(base + off_ + 128); \
            pw[slot][0] = *(const u32x4*)(pp + off_); pw[slot][1] = *(const u32x4*)(pp + off_ + 128); } while (0)
        EP_LOAD(0, 0);
#pragma unroll
        for (int q = 0; q < 8; ++q) {
            const int ai = q >> 2, m = q & 3, sl = q & 1;
            if (q + 1 < 8) EP_LOAD((q + 1) & 1, q + 1);
            SCHED_FENCE();
            const int row = row0 + ai * 128 + m * 16;
            const size_t off = (size_t)row * D_ + col0;
            const float rsv = rs[ai][m];
            float s = 0.f;
#pragma unroll
            for (int bj = 0; bj < 2; ++bj) {
                float pf[8], xf[8]; unpack8(pw[sl][bj], pf); unpack8(r[sl][bj], xf);
                f32x4 v0, v1;
#pragma unroll
                for (int j = 0; j < 4; ++j) { v0[j] = xf[j] + sigm(acc[ai][bj][m][0][j] * rsv) * pf[j]; v1[j] = xf[4 + j] + sigm(acc[ai][bj][m][1][j] * rsv) * pf[4 + j]; }
                u32x4 w; w.x = pk_bf16(v0[0], v0[1]); w.y = pk_bf16(v0[2], v0[3]); w.z = pk_bf16(v1[0], v1[1]); w.w = pk_bf16(v1[2], v1[3]);
                *(u32x4*)(ob + off + bj * 128) = w;
                s += (v0[0] * v0[0] + v0[1] * v0[1]) + (v0[2] * v0[2] + v0[3] * v0[3]) + (v1[0] * v1[0] + v1[1] * v1[1]) + (v1[2] * v1[2] + v1[3] * v1[3]);
            }
            s += __shfl_xor(s, 16); s += __shfl_xor(s, 32);
            if (fq == 0) ssout[(size_t)row * 32 + u.pn * 4 + wc] = s;
            SCHED_FENCE();
        }
#undef EP_LOAD
    }
};

struct EpiPleFinal {
    static constexpr bool PERM = true, AFTER_DRAIN = true, APERM = false;
    const bf16_t* base; const bf16_t* pp; const float* ssin; float* ssx; unsigned* cnt; const float* gf; float* out;
    __device__ __forceinline__ void fused(const f32x4 (&acc)[2][2][4][2], const Unit& u, int wr, int wc, int fr, int fq, LAS unsigned char*, int, int) const {
        const int row0 = u.pm * 256 + wr * 64 + fr, col0 = u.pn * 256 + wc * 32 + 8 * fq;
        float rs[2][4];
        rstd_rows(ssin, row0, fq, rs);
        u32x4 xk[8][2];
        u32x4 r[2][2], pw[2][2];
#define EP_LOAD(slot, q) do { const size_t off_ = (size_t)(row0 + ((q) >> 2) * 128 + ((q) & 3) * 16) * D_ + col0; \
            r[slot][0] = *(const u32x4*)(base + off_); r[slot][1] = *(const u32x4*)(base + off_ + 128); \
            pw[slot][0] = *(const u32x4*)(pp + off_); pw[slot][1] = *(const u32x4*)(pp + off_ + 128); } while (0)
        EP_LOAD(0, 0);
#pragma unroll
        for (int q = 0; q < 8; ++q) {
            const int ai = q >> 2, m = q & 3, sl = q & 1;
            if (q + 1 < 8) EP_LOAD((q + 1) & 1, q + 1);
            SCHED_FENCE();
            const int row = row0 + ai * 128 + m * 16;
            const float rsv = rs[ai][m];
            float s = 0.f;
#pragma unroll
            for (int bj = 0; bj < 2; ++bj) {
                float pf[8], xf[8]; unpack8(pw[sl][bj], pf); unpack8(r[sl][bj], xf);
                f32x4 v0, v1;
#pragma unroll
                for (int j = 0; j < 4; ++j) { v0[j] = xf[j] + sigm(acc[ai][bj][m][0][j] * rsv) * pf[j]; v1[j] = xf[4 + j] + sigm(acc[ai][bj][m][1][j] * rsv) * pf[4 + j]; }
                u32x4 w; w.x = pk_bf16(v0[0], v0[1]); w.y = pk_bf16(v0[2], v0[3]); w.z = pk_bf16(v1[0], v1[1]); w.w = pk_bf16(v1[2], v1[3]);
                xk[q][bj] = w;
                s += (v0[0] * v0[0] + v0[1] * v0[1]) + (v0[2] * v0[2] + v0[3] * v0[3]) + (v1[0] * v1[0] + v1[1] * v1[1]) + (v1[2] * v1[2] + v1[3] * v1[3]);
            }
            s += __shfl_xor(s, 16); s += __shfl_xor(s, 32);
            if (fq == 0) __hip_atomic_store(ssx + (size_t)row * 32 + u.pn * 4 + wc, s, __ATOMIC_RELAXED, __HIP_MEMORY_SCOPE_AGENT);
            SCHED_FENCE();
        }
#undef EP_LOAD
        asm volatile("s_waitcnt vmcnt(0)" ::: "memory");
        unsigned* const c = cnt + 64 * u.pm;
        if (fr == 0 && fq == 0) __hip_atomic_fetch_add(c, 1u, __ATOMIC_RELAXED, __HIP_MEMORY_SCOPE_AGENT);
        if (wr == 0 && wc == 0) {
            for (unsigned spins = 0; spins < (1u << 22); ++spins) {
                if ((unsigned)__builtin_amdgcn_readfirstlane((int)__hip_atomic_load(c, __ATOMIC_RELAXED, __HIP_MEMORY_SCOPE_AGENT)) >= 64u) break;
                __builtin_amdgcn_s_sleep(1);
            }
            __builtin_amdgcn_fence(__ATOMIC_ACQUIRE, "agent");
            asm volatile("s_waitcnt vmcnt(0)" ::: "memory");
        }
        __builtin_amdgcn_s_barrier();
        asm volatile("" ::: "memory");
        float rs3[2][4];
        rstd_rows(ssx, row0, fq, rs3);
        f32x4 gfv[2][2];
#pragma unroll
        for (int bj = 0; bj < 2; ++bj) { gfv[bj][0] = *(const f32x4*)(gf + col0 + bj * 128); gfv[bj][1] = *(const f32x4*)(gf + col0 + bj * 128 + 4); }
#pragma unroll
        for (int q = 0; q < 8; ++q) {
            const int ai = q >> 2, m = q & 3;
            const size_t off = (size_t)(row0 + ai * 128 + m * 16) * D_ + col0;
            const float rv = rs3[ai][m];
#pragma unroll
            for (int bj = 0; bj < 2; ++bj) {
                float f[8]; unpack8(xk[q][bj], f);
                *(f32x4*)(out + off + bj * 128) = (f32x4){f[0], f[1], f[2], f[3]} * rv * gfv[bj][0];
                *(f32x4*)(out + off + bj * 128 + 4) = (f32x4){f[4], f[5], f[6], f[7]} * rv * gfv[bj][1];
            }
        }
    }
};

__device__ void phase_convgroup(const Params& p, const int wv) {
    const bf16_t* proj = (const bf16_t*)(p.ws + WS_PROJ);
    bf16_t* y = (bf16_t*)(p.ws + WS_Y);
    const float* cw = p.in[6];
    for (int it = blockIdx.x * 512 + TID_X; it < (T_ / 8) * 128; it += gridDim.x * 512) {
        const int cc = it & 127, run = it >> 7, c = cc * 8, t0 = run * 8;
        float w0[8], w1[8], w2[8], p2[8], p1[8];
#pragma unroll
        for (int j = 0; j < 8; ++j) { w0[j] = cw[c + j]; w1[j] = cw[1024 + c + j]; w2[j] = cw[2048 + c + j]; p2[j] = 0.f; p1[j] = 0.f; }
        if ((t0 & (SEQ_ - 1)) != 0) {
            float a[8], b[8];
            unpack8(*(const u32x4*)(proj + (size_t)(t0 - 2) * NP_ + 1024 + c), a); unpack8(*(const u32x4*)(proj + (size_t)(t0 - 2) * NP_ + 2048 + c), b);
#pragma unroll
            for (int j = 0; j < 8; ++j) p2[j] = a[j] * b[j];
            unpack8(*(const u32x4*)(proj + (size_t)(t0 - 1) * NP_ + 1024 + c), a); unpack8(*(const u32x4*)(proj + (size_t)(t0 - 1) * NP_ + 2048 + c), b);
#pragma unroll
            for (int j = 0; j < 8; ++j) p1[j] = a[j] * b[j];
        }
#pragma unroll
        for (int dt = 0; dt < 8; ++dt) {
            const size_t ro = (size_t)(t0 + dt) * NP_;
            float gb[8], gc[8], uu[8], o[8];
            unpack8(*(const u32x4*)(proj + ro + c), gb); unpack8(*(const u32x4*)(proj + ro + 1024 + c), gc); unpack8(*(const u32x4*)(proj + ro + 2048 + c), uu);
#pragma unroll
            for (int j = 0; j < 8; ++j) { const float cur = gc[j] * uu[j]; o[j] = gb[j] * (w0[j] * p2[j] + w1[j] * p1[j] + w2[j] * cur); p2[j] = p1[j]; p1[j] = cur; }
            *(u32x4*)(y + (size_t)(t0 + dt) * D_ + c) = pack8(o);
        }
    }
}

constexpr int ML_KOFF = 0, ML_KSZ = 64 * 272, ML_VOFF = 2 * ML_KSZ, ML_VSZ = 256 * 144, ML_AOFF = ML_VOFF + 2 * ML_VSZ, ML_AROFF = ML_AOFF + 512, ML_SSOFF = ML_AROFF + 512;
__device__ __forceinline__ void ml_compute(LAS unsigned char* lds, const int buf, const bool diag, const int tl, const int g, const int tb, const int vh,
                                           const bf16x8 (&qf)[4], const float Mt, const float amax, f32x4 (&oacc)[8], float& den) {
    constexpr int KOFF = ML_KOFF, KSZ = ML_KSZ, VOFF = ML_VOFF, VSZ = ML_VSZ, AOFF = ML_AOFF, AROFF = ML_AROFF;
    LAS unsigned char* const kfb = lds + tl * 272 + g * 16;
    LAS unsigned char* const afb = lds + g * 16;
    LAS unsigned char* vfb[4];
#pragma unroll
    for (int x = 0; x < 4; ++x) vfb[x] = lds + (vh * 128 + tl) * 144 + ((g ^ x) << 4);
                u32x4 pf[2];
                f32x4 sa[4];
#pragma unroll
                for (int sh = 0; sh < 2; ++sh) {
                    bf16x8 kf[2][4];
#pragma unroll
                    for (int s2 = 0; s2 < 2; ++s2)
#pragma unroll
                        for (int kk = 0; kk < 4; ++kk) kf[s2][kk] = *(const LAS bf16x8*)(kfb + (KOFF + buf * KSZ + 16 * (2 * sh + s2) * 272 + 64 * kk));
                    SCHED_FENCE();
                    sa[2 * sh] = (f32x4){0.f, 0.f, 0.f, 0.f}; sa[2 * sh + 1] = (f32x4){0.f, 0.f, 0.f, 0.f};
#pragma unroll
                    for (int kk = 0; kk < 4; ++kk)
#pragma unroll
                        for (int s2 = 0; s2 < 2; ++s2) sa[2 * sh + s2] = __builtin_amdgcn_mfma_f32_16x16x32_bf16(kf[s2][kk], qf[kk], sa[2 * sh + s2], 0, 0, 0);
                    SCHED_FENCE();
                }
                bf16x8 vf[4];
#pragma unroll
                for (int i = 0; i < 4; ++i) { const int nb = i >> 1, k2 = i & 1;
                    vf[i] = *(const LAS bf16x8*)(vfb[nb & 3] + (VOFF + buf * VSZ + nb * 16 * 144 + (((k2 << 2) ^ (nb & 4)) << 4))); }
                f32x4 a4[4];
                if (!diag) {
#pragma unroll
                    for (int sb = 0; sb < 4; ++sb) a4[sb] = *(const LAS f32x4*)(afb + (AOFF + buf * 256 + 64 * sb));
                    SCHED_FENCE();
                    const float et = __expf(amax - Mt);
#pragma unroll
                    for (int sb = 0; sb < 4; ++sb) {
                        const f32x4 pv = sa[sb] * (a4[sb] * et);
                        den += (pv[0] + pv[1]) + (pv[2] + pv[3]);
                        const unsigned lo = pk_bf16(pv[0], pv[1]), hi = pk_bf16(pv[2], pv[3]);
                        if (sb & 1) { pf[sb >> 1].z = lo; pf[sb >> 1].w = hi; } else { pf[sb >> 1].x = lo; pf[sb >> 1].y = hi; }
                    }
                } else {
#pragma unroll
                    for (int sb = 0; sb < 4; ++sb) a4[sb] = *(const LAS f32x4*)(afb + (AROFF + buf * 256 + 64 * sb));
                    SCHED_FENCE();
#pragma unroll
                    for (int sb = 0; sb < 4; ++sb) {
                        float pv[4];
#pragma unroll
                        for (int j = 0; j < 4; ++j) {
                            float w = __expf(a4[sb][j] - Mt);
                            if ((16 * sb + 4 * g + j) > (tb * 16 + tl)) w = 0.f;
                            pv[j] = sa[sb][j] * w; den += pv[j];
                        }
                        const unsigned lo = pk_bf16(pv[0], pv[1]), hi = pk_bf16(pv[2], pv[3]);
                        if (sb & 1) { pf[sb >> 1].z = lo; pf[sb >> 1].w = hi; } else { pf[sb >> 1].x = lo; pf[sb >> 1].y = hi; }
                    }
                }
                SCHED_FENCE();
                const bf16x8 pb0 = __builtin_bit_cast(bf16x8, pf[0]), pb1 = __builtin_bit_cast(bf16x8, pf[1]);
#pragma unroll
                for (int qd = 0; qd < 4; ++qd) {
#pragma unroll
                    for (int i = 0; i < 4; ++i) oacc[2 * qd + (i >> 1)] = __builtin_amdgcn_mfma_f32_16x16x32_bf16(vf[i], (i & 1) ? pb1 : pb0, oacc[2 * qd + (i >> 1)], 0, 0, 0);
                    if (qd < 3) {
#pragma unroll
                        for (int i = 0; i < 4; ++i) { const int nb = 2 * (qd + 1) + (i >> 1), k2 = i & 1;
                            vf[i] = *(const LAS bf16x8*)(vfb[nb & 3] + (VOFF + buf * VSZ + nb * 16 * 144 + (((k2 << 2) ^ (nb & 4)) << 4))); }
                        SCHED_FENCE();
                    }
                }
}

__device__ void phase_mlstm(const Params& p, LAS unsigned char* lds, const int wv) {
    const int wid = wv, lane = lane_id(), tid = wv * 64 + lane, tl = lane & 15, g = lane >> 4, tb = wid & 3, vh = wid >> 2;
    const bf16_t* proj = (const bf16_t*)(p.ws + WS_PROJ);
    bf16_t* y = (bf16_t*)(p.ws + WS_Y);
    const float* acum = (const float*)(p.ws + WS_SMALL + SM_ACUM);
    const float* mrun = (const float*)(p.ws + WS_SMALL + SM_MRUN);
    const float* bcum = (const float*)(p.ws + WS_SMALL + SM_BCUM);
    constexpr int KOFF = ML_KOFF, KSZ = ML_KSZ, VOFF = ML_VOFF, VSZ = ML_VSZ, AOFF = ML_AOFF, AROFF = ML_AROFF, SSOFF = ML_SSOFF;
    for (int pr = blockIdx.x; pr < 256; pr += gridDim.x) {
        const int xx = pr & 7, jj = pr >> 3;
        const int bh = 2 * xx + (jj >> 4), ip = jj & 15, batch = bh >> 2, h = bh & 3;
        for (int which = 0; which < 2; ++which) {
            const int qi = which ? ip : 31 - ip;
            const int trow = batch * SEQ_ + qi * 64 + tb * 16 + tl;
            const int sidx = bh * SEQ_ + qi * 64 + tb * 16 + tl;
            bf16x8 qf[4];
#pragma unroll
            for (int kk = 0; kk < 4; ++kk) qf[kk] = *(const bf16x8*)(proj + (size_t)trow * NP_ + 3072 + h * 128 + 32 * kk + 8 * g);
            const float Mt = mrun[sidx];
            f32x4 oacc[8];
#pragma unroll
            for (int nb = 0; nb < 8; ++nb) oacc[nb] = (f32x4){0.f, 0.f, 0.f, 0.f};
            float den = 0.f;
            u32x4 kreg[2][2], vreg[2][4]; float areg[2] = {0.f, 0.f}, amaxr[2] = {0.f, 0.f};
            const bf16_t* kbase = proj + (size_t)batch * SEQ_ * NP_ + 3584 + h * 128;
            const bf16_t* vbase = proj + (size_t)batch * SEQ_ * NP_ + 4096 + h * 256;
            const unsigned koff = (unsigned)((tid >> 4) * NP_ + (tid & 15) * 8), voff = (unsigned)(4 * (tid & 15) * NP_ + (tid >> 4) * 8);
#define ML_LOAD(kj, S) do { \
                { const bf16_t* kt_ = kbase + (size_t)(kj) * 64 * NP_; const bf16_t* vt_ = vbase + (size_t)(kj) * 64 * NP_; \
                  kreg[S][0] = *(const u32x4*)(kt_ + koff); kreg[S][1] = *(const u32x4*)(kt_ + 32 * NP_ + koff); \
                  _Pragma("unroll") for (int ii = 0; ii < 4; ++ii) vreg[S][ii] = *(const u32x4*)(vt_ + ii * NP_ + voff); } \
                areg[S] = acum[bh * SEQ_ + (kj) * 64 + (tid & 63)]; } while (0)
#define ML_STORE(buf, S) do { \
                _Pragma("unroll") for (int ii = 0; ii < 2; ++ii) { const int ch = tid + 512 * ii; *(LAS u32x4*)(lds + KOFF + (buf) * KSZ + (ch >> 4) * 272 + (ch & 15) * 16) = kreg[S][ii]; } \
                { const int sq = tid & 15, vc = tid >> 4; \
                  const int grp = ((sq >> 3) << 2) | (sq & 3), half = (sq >> 2) & 1; \
                  LAS unsigned char* vb = lds + VOFF + (buf) * VSZ + (vc * 8) * 144 + ((grp ^ ((vc >> 1) & 7)) << 4) + (half << 3); \
                  _Pragma("unroll") for (int d = 0; d < 4; ++d) { \
                      const unsigned a0 = vreg[S][0][d], a1 = vreg[S][1][d], a2 = vreg[S][2][d], a3 = vreg[S][3][d]; \
                      u32x2 ev, od; ev.x = (a0 & 0xffffu) | (a1 << 16); ev.y = (a2 & 0xffffu) | (a3 << 16); od.x = (a0 >> 16) | (a1 & 0xffff0000u); od.y = (a2 >> 16) | (a3 & 0xffff0000u); \
                      *(LAS u32x2*)(vb + (2 * d) * 144) = ev; *(LAS u32x2*)(vb + (2 * d + 1) * 144) = od; } } \
                { const float mx_ = wave_scan_max(areg[S]); amaxr[S] = __builtin_bit_cast(float, __builtin_amdgcn_readlane(__builtin_bit_cast(int, mx_), 63)); \
                  *(LAS float*)(lds + AOFF + (buf) * 256 + (tid & 63) * 4) = __expf(areg[S] - amaxr[S]); *(LAS float*)(lds + AROFF + (buf) * 256 + (tid & 63) * 4) = areg[S]; } } while (0)
            ML_LOAD(0, 0);
            ML_LOAD(min(1, qi), 1);
            ML_STORE(0, 0);
            __syncthreads();
            for (int kj = 0; kj <= qi; kj += 2) {
                ML_LOAD(min(kj + 2, qi), 0);
                ml_compute(lds, 0, kj == qi, tl, g, tb, vh, qf, Mt, amaxr[0], oacc, den);
                ML_STORE(1, 1);
                __syncthreads();
                if (kj + 1 > qi) break;
                ML_LOAD(min(kj + 3, qi), 1);
                ml_compute(lds, 1, kj + 1 == qi, tl, g, tb, vh, qf, Mt, amaxr[1], oacc, den);
                ML_STORE(0, 0);
                __syncthreads();
            }
#undef ML_LOAD
#undef ML_STORE
            den += __shfl_xor(den, 16); den += __shfl_xor(den, 32);
            const float mt = bcum[sidx] + Mt;
            const float inv = 1.0f / fmaxf(fabsf(den), __expf(-mt));
            float ssq = 0.f;
#pragma unroll
            for (int nb = 0; nb < 8; ++nb) { oacc[nb] *= inv; ssq += (oacc[nb][0] * oacc[nb][0] + oacc[nb][1] * oacc[nb][1]) + (oacc[nb][2] * oacc[nb][2] + oacc[nb][3] * oacc[nb][3]); }
            ssq += __shfl_xor(ssq, 16); ssq += __shfl_xor(ssq, 32);
            LAS float* SS = (LAS float*)(lds + SSOFF);
            if (g == 0) SS[vh * 64 + tb * 16 + tl] = ssq;
            __syncthreads();
            const float tot = SS[tb * 16 + tl] + SS[64 + tb * 16 + tl];
            const float rs = rsqrtf(tot * (1.0f / 256.0f) + EPS_);
            __syncthreads();
#pragma unroll
            for (int nb = 0; nb < 8; ++nb) {
                const int v = h * 256 + vh * 128 + nb * 16 + 4 * g;
                const u32x2 ow = *(const u32x2*)(proj + (size_t)trow * NP_ + 5120 + v);
                const f32x4 gm = *(const f32x4*)(p.in[7] + v);
                const float o0 = sigm(bflo(ow.x)) * oacc[nb][0] * rs * gm.x, o1 = sigm(bfhi(ow.x)) * oacc[nb][1] * rs * gm.y;
                const float o2 = sigm(bflo(ow.y)) * oacc[nb][2] * rs * gm.z, o3 = sigm(bfhi(ow.y)) * oacc[nb][3] * rs * gm.w;
                u32x2 ov; ov.x = pk_bf16(o0, o1); ov.y = pk_bf16(o2, o3);
                *(u32x2*)(y + (size_t)trow * D_ + 1024 + v) = ov;
            }
        }
    }
}

__device__ void phase_act(const Params& p, const int wv) {
    const bf16_t* up = (const bf16_t*)(p.ws + WS_UP);
    bf16_t* act = (bf16_t*)(p.ws + WS_ACT);
    const float* cw = p.in[11]; const float* cb = p.in[12];
    constexpr int NCH = DFF_ / 8;
    const int vblk = ((gridDim.x & 7u) == 0u) ? (int)((blockIdx.x & 7u) * (gridDim.x >> 3) + (blockIdx.x >> 3)) : (int)blockIdx.x;
    for (int it = vblk * 512 + TID_X; it < (T_ / 8) * NCH; it += gridDim.x * 512) {
        const int cc = it % NCH, run = it / NCH, c = cc * 8, t0 = run * 8;
        const bool first = (t0 & (SEQ_ - 1)) == 0;
        u32x4 gr[10], ur[10];
#pragma unroll
        for (int d = 0; d < 10; ++d) {
            const int t = (first && d < 2) ? t0 : t0 + d - 2;
            if (d < 2 || d >= 8) {
                gr[d] = *(const u32x4*)(up + (size_t)t * NUP_ + c); ur[d] = *(const u32x4*)(up + (size_t)t * NUP_ + DFF_ + c);
            } else {
                gr[d] = __builtin_nontemporal_load((const u32x4*)(up + (size_t)t * NUP_ + c)); ur[d] = __builtin_nontemporal_load((const u32x4*)(up + (size_t)t * NUP_ + DFF_ + c));
            }
        }
        f32x4 wgv[4][2], wuv[4][2];
#pragma unroll
        for (int k = 0; k < 3; ++k)
#pragma unroll
            for (int hh = 0; hh < 2; ++hh) { wgv[k][hh] = *(const f32x4*)(cw + k * NUP_ + c + 4 * hh); wuv[k][hh] = *(const f32x4*)(cw + k * NUP_ + DFF_ + c + 4 * hh); }
#pragma unroll
        for (int hh = 0; hh < 2; ++hh) { wgv[3][hh] = *(const f32x4*)(cb + c + 4 * hh); wuv[3][hh] = *(const f32x4*)(cb + DFF_ + c + 4 * hh); }
        SCHED_FENCE();
        float g2[8], g1[8], u2[8], u1[8];
        unpack8(gr[0], g2); unpack8(ur[0], u2); unpack8(gr[1], g1); unpack8(ur[1], u1);
        if (first) {
#pragma unroll
            for (int j = 0; j < 8; ++j) { g2[j] = 0.f; g1[j] = 0.f; u2[j] = 0.f; u1[j] = 0.f; }
        }
#pragma unroll
        for (int dt = 0; dt < 8; ++dt) {
            float g0[8], u0[8], o[8];
            unpack8(gr[dt + 2], g0); unpack8(ur[dt + 2], u0);
#pragma unroll
            for (int j = 0; j < 8; ++j) {
                const float G = wgv[0][j >> 2][j & 3] * g2[j] + wgv[1][j >> 2][j & 3] * g1[j] + wgv[2][j >> 2][j & 3] * g0[j] + wgv[3][j >> 2][j & 3];
                const float U = wuv[0][j >> 2][j & 3] * u2[j] + wuv[1][j >> 2][j & 3] * u1[j] + wuv[2][j >> 2][j & 3] * u0[j] + wuv[3][j >> 2][j & 3];
                o[j] = G * sigm(G) * U;
                g2[j] = g1[j]; g1[j] = g0[j]; u2[j] = u1[j]; u1[j] = u0[j];
            }
            *(u32x4*)(act + (size_t)(t0 + dt) * DFF_ + c) = pack8(o);
        }
    }
}

__device__ void phase_final(const Params& p, const int wv) {
    const int wid = wv, lane = lane_id();
    const float* ss = (const float*)(p.ws + WS_SMALL + SM_SSA);
    const bf16_t* x3b = (const bf16_t*)(p.ws + WS_X3B);
    const float* gf = p.in[17];
    f32x4 g0[4], g1[4];
#pragma unroll
    for (int i = 0; i < 4; ++i) { const int k = (i * 64 + lane) * 8; g0[i] = *(const f32x4*)(gf + k); g1[i] = *(const f32x4*)(gf + k + 4); }
    for (int rb = (blockIdx.x * 8 + wid) * 4; rb < T_; rb += gridDim.x * 8 * 4) {
        float sp[4]; u32x4 w[4][4];
#pragma unroll
        for (int r = 0; r < 4; ++r) {
            sp[r] = (lane < 32) ? ss[(size_t)(rb + r) * 32 + lane] : 0.f;
#pragma unroll
            for (int i = 0; i < 4; ++i) w[r][i] = *(const u32x4*)(x3b + (size_t)(rb + r) * D_ + (i * 64 + lane) * 8);
        }
#pragma unroll
        for (int r = 0; r < 4; ++r) {
            const float rs = rsqrtf(wave_sum(sp[r]) * (1.0f / D_) + EPS_);
            float* xr = p.out + (size_t)(rb + r) * D_;
#pragma unroll
            for (int i = 0; i < 4; ++i) {
                const int k = (i * 64 + lane) * 8;
                float f[8]; unpack8(w[r][i], f);
                *(f32x4*)(xr + k) = (f32x4){f[0], f[1], f[2], f[3]} * rs * g0[i];
                *(f32x4*)(xr + k + 4) = (f32x4){f[4], f[5], f[6], f[7]} * rs * g1[i];
            }
        }
    }
}

__device__ __forceinline__ unsigned xcc_id() { return (unsigned)__builtin_amdgcn_s_getreg((3 << 11) | 20) & 7u; }
__device__ __forceinline__ void grid_barrier(unsigned* bar, const unsigned k, const int wv) {
    asm volatile("s_waitcnt vmcnt(0) lgkmcnt(0)" ::: "memory");
    __builtin_amdgcn_s_barrier();
    if (wv == 0) {
        const unsigned x = xcc_id();
        unsigned last = 0;
        if (lane_id() == 0) {
            if (k == 1u) {
                for (;;) { unsigned tot = 0;
                    for (int j = 0; j < 8; ++j) tot += __hip_atomic_load(bar + 64 * (9 + j), __ATOMIC_RELAXED, __HIP_MEMORY_SCOPE_AGENT);
                    if (tot >= gridDim.x) break; __builtin_amdgcn_s_sleep(1); } }
            const unsigned n = __hip_atomic_load(bar + 64 * (9 + x), __ATOMIC_RELAXED, __HIP_MEMORY_SCOPE_AGENT);
            const unsigned old = __hip_atomic_fetch_add(bar + 64 * (1 + x), 1u, __ATOMIC_RELAXED, __HIP_MEMORY_SCOPE_AGENT);
            last = (old + 1u == n * k) ? 1u : 0u;
        }
        last = (unsigned)__builtin_amdgcn_readfirstlane((int)last);
        if (last) {
            __builtin_amdgcn_fence(__ATOMIC_RELEASE, "agent");
            asm volatile("s_waitcnt vmcnt(0)" ::: "memory");
            if (lane_id() == 0) __hip_atomic_fetch_add(bar, 1u, __ATOMIC_RELAXED, __HIP_MEMORY_SCOPE_AGENT);
        }
        if (lane_id() == 0) {
            unsigned nx = 0;
            for (int j = 0; j < 8; ++j) nx += __hip_atomic_load(bar + 64 * (9 + j), __ATOMIC_RELAXED, __HIP_MEMORY_SCOPE_AGENT) ? 1u : 0u;
            while (__hip_atomic_load(bar, __ATOMIC_RELAXED, __HIP_MEMORY_SCOPE_AGENT) < nx * k) __builtin_amdgcn_s_sleep(1);
        }
        __builtin_amdgcn_fence(__ATOMIC_ACQUIRE, "agent");
        asm volatile("s_waitcnt vmcnt(0)" ::: "memory");
    }
    __builtin_amdgcn_s_barrier();
}

constexpr int N_PHASES = 8;
__global__ void __launch_bounds__(512, 2) fwd_kernel(Params p) {
    extern __shared__ __attribute__((aligned(16))) unsigned char lds_raw[];
    LAS unsigned char* lds = (LAS unsigned char*)lds_raw;
    unsigned char* ws = p.ws;
    pg8::StaticOrder S;
    const int wv = __builtin_amdgcn_readfirstlane((int)(threadIdx.x >> 6));
    unsigned* const gbar = (unsigned*)(ws + WS_SMALL + SM_BAR);
    unsigned nbar = 0;
#define PHASE_BEGIN(n) if (p.ph_lo <= (n) && (n) < p.ph_hi) {
#define PHASE_END(n) if ((n) + 1 < p.ph_hi) { ++nbar; grid_barrier(gbar, nbar, wv); } }
#define PHASE_END_CG(n) if ((n) + 1 < p.ph_hi) cg::this_grid().sync(); }
    if (p.ph_lo == 0 && p.ph_hi > 1) {
        if (blockIdx.x == 0 && threadIdx.x < 17) __hip_atomic_store(gbar + 64 * threadIdx.x, 0u, __ATOMIC_RELAXED, __HIP_MEMORY_SCOPE_AGENT);
        if (blockIdx.x == 1 && threadIdx.x < 32) __hip_atomic_store((unsigned*)(ws + WS_SMALL + SM_CNT) + 64 * threadIdx.x, 0u, __ATOMIC_RELAXED, __HIP_MEMORY_SCOPE_AGENT);
        cg::this_grid().sync();
        if (wv == 0 && lane_id() == 0) __hip_atomic_fetch_add(gbar + 64 * (9 + xcc_id()), 1u, __ATOMIC_RELAXED, __HIP_MEMORY_SCOPE_AGENT);
    }
    PHASE_BEGIN(0)
        phase_prep(p, lds, wv);
    PHASE_END(0)
    PHASE_BEGIN(1)
        if (wv == 0) for (int bh = blockIdx.x; bh < 16; bh += gridDim.x)
            scan_gates((const float*)(ws + WS_SMALL + SM_GATES), (float*)(ws + WS_SMALL + SM_ACUM), (float*)(ws + WS_SMALL + SM_MRUN), (float*)(ws + WS_SMALL + SM_BCUM), bh, lane_id());
        { pg8::Gemm g{(const bf16_t*)(ws + WS_XB), (const bf16_t*)(ws + WS_WIN), T_, NP_, D_}; S.init(T_, NP_, gridDim.x, blockIdx.x);
          EpiBf16Scale E{(bf16_t*)(ws + WS_PROJ), NP_, (const float*)(ws + WS_SMALL + SM_RSTD0)}; pg8::gemm_phase(lds, g, S, E, wv); }
    PHASE_END(1)
    PHASE_BEGIN(2)
        phase_convgroup(p, wv);
        phase_mlstm(p, lds, wv);
    PHASE_END(2)
    PHASE_BEGIN(3)
        { pg8::Gemm g{(const bf16_t*)(ws + WS_Y), (const bf16_t*)(ws + WS_WOUT), T_, D_, D_}; S.init(T_, D_, gridDim.x, blockIdx.x);
          EpiResidBf E{(const bf16_t*)(ws + WS_XB), (bf16_t*)p.out, (float*)(ws + WS_SMALL + SM_SSA)}; pg8::gemm_phase(lds, g, S, E, wv); }
    PHASE_END(3)
    PHASE_BEGIN(4)
        { pg8::Gemm g{(const bf16_t*)p.out, (const bf16_t*)(ws + WS_WUP), T_, NUP_, D_}; S.init(T_, NUP_, gridDim.x, blockIdx.x);
          EpiBf16Norm E{(bf16_t*)(ws + WS_UP), NUP_, (const float*)(ws + WS_SMALL + SM_SSA)}; pg8::gemm_phase(lds, g, S, E, wv); }
        { const int nunits = (T_ / 256) * (NUP_ / 256), nfull = nunits % (int)gridDim.x;
          const int worker = nfull ? (int)blockIdx.x - nfull : (int)blockIdx.x, nworkers = nfull ? (int)gridDim.x - nfull : (int)gridDim.x;
          if (worker >= 0) {
              convert_tiles(p, lds, NT_EARLY, NT_ALL, worker, nworkers, wv);
              __syncthreads();
              pg8::Gemm g2{(const bf16_t*)p.out + OUT_PB, (const bf16_t*)p.out + OUT_WPP, T_, D_, DPLE_}; S.init(T_, D_, nworkers, worker);
              EpiBf16Scale E2{(bf16_t*)(ws + WS_PP), D_, nullptr}; pg8::gemm_phase(lds, g2, S, E2, wv); } }
    PHASE_END(4)
    PHASE_BEGIN(5)
        phase_act(p, wv);
    PHASE_END(5)
    PHASE_BEGIN(6)
        { pg8::Gemm g{(const bf16_t*)(ws + WS_ACT), (const bf16_t*)(ws + WS_WDOWN), T_, D_, DFF_}; S.init(T_, D_, gridDim.x, blockIdx.x);
          EpiResidBf E{(const bf16_t*)p.out, (bf16_t*)(ws + WS_X2B2), (float*)(ws + WS_SMALL + SM_SSB)}; pg8::gemm_phase(lds, g, S, E, wv); }
    PHASE_END(6)
    PHASE_BEGIN(7)
        { pg8::Gemm g{(const bf16_t*)(ws + WS_X2B2), (const bf16_t*)(ws + WS_WPG), T_, D_, D_}; S.init(T_, D_, gridDim.x, blockIdx.x);
          EpiPleFinal E{(const bf16_t*)(ws + WS_X2B2), (const bf16_t*)(ws + WS_PP), (const float*)(ws + WS_SMALL + SM_SSB), (float*)(ws + WS_SMALL + SM_SSA),
                        (unsigned*)(ws + WS_SMALL + SM_CNT), p.in[17], p.out}; pg8::gemm_phase(lds, g, S, E, wv); }
    PHASE_END(7)
}

extern "C" void kernel_launch(void* const* d_in, const int* in_sizes, int n_in, void* d_out, int out_size, void* d_ws, size_t ws_size, hipStream_t stream) {
    static int grid = 0;
    if (grid == 0) {
        if (n_in != 18 || out_size != T_ * D_ || ws_size < WS_END) { fprintf(stderr, "kernel_launch: unexpected shapes: n_in %d out %d ws %zu (need %zu)\n", n_in, out_size, ws_size, (size_t)WS_END); grid = -1; return; }
        int dev = 0, cus = 0, per_cu = 0;
        hipGetDevice(&dev);
        hipDeviceGetAttribute(&cus, hipDeviceAttributeMultiprocessorCount, dev);
        if (hipFuncSetAttribute((const void*)fwd_kernel, hipFuncAttributeMaxDynamicSharedMemorySize, LDS_BYTES) != hipSuccess) { fprintf(stderr, "kernel_launch: hipFuncSetAttribute failed\n"); grid = -1; return; }
        if (hipOccupancyMaxActiveBlocksPerMultiprocessor(&per_cu, (const void*)fwd_kernel, 512, LDS_BYTES) != hipSuccess || per_cu < 1) { fprintf(stderr, "kernel_launch: occupancy query says %d\n", per_cu); per_cu = 1; (void)hipGetLastError(); }
        grid = cus * per_cu;
        if (grid > 256) grid = 256;
        fprintf(stderr, "kernel_launch: grid %d (cus %d x %d), ws %zu\n", grid, cus, per_cu, ws_size);
    }
    if (grid < 0) return;
    Params prm{};
    for (int i = 0; i < 18; ++i) prm.in[i] = (const float*)d_in[i];
    prm.out = (float*)d_out; prm.ws = (unsigned char*)d_ws;
#if N_LAUNCH_MODE == 1
    prm.ph_lo = 0; prm.ph_hi = N_PHASES;
    void* args[] = {&prm};
    hipError_t e = hipLaunchCooperativeKernel((const void*)fwd_kernel, dim3(grid), dim3(512), args, LDS_BYTES, stream);
    if (e != hipSuccess) fprintf(stderr, "kernel_launch: cooperative launch failed: %s (grid %d)\n", hipGetErrorString(e), grid);
#else
    for (int ph = 0; ph < N_PHASES; ++ph) {
        prm.ph_lo = ph; prm.ph_hi = ph + 1;
        hipLaunchKernelGGL(fwd_kernel, dim3(grid), dim3(512), LDS_BYTES, stream, prm);
    }
#endif
}
```

```cpp
#include <hip/hip_runtime.h>
#include <hip/hip_cooperative_groups.h>
#include <cstdio>
namespace cg = cooperative_groups;
#ifndef N_LAUNCH_MODE
#define N_LAUNCH_MODE 1
#endif
__device__ __forceinline__ int lane_id() { return (int)__builtin_amdgcn_mbcnt_hi(~0u, __builtin_amdgcn_mbcnt_lo(~0u, 0u)); }
#define TID_X (wv * 64 + lane_id())
namespace pg8 {
#define PG8_LAS __attribute__((address_space(3)))
typedef unsigned short bf16_t;
typedef short bf16x8 __attribute__((ext_vector_type(8)));
typedef float f32x4 __attribute__((ext_vector_type(4)));
typedef unsigned u32x4 __attribute__((ext_vector_type(4)));
constexpr int BM = 256, BK = 64, HALF = 128, HTB = HALF * BK * 2  , STAGE_BYTES = 8 * HTB, NXCD = 8, WGM = 8;

__host__ __device__ __forceinline__ int lds_byte(int r, int c) { const int st = (r >> 4) * 2 + (c >> 5), rr = r & 15, cc = c & 31, ob = rr * 64 + cc * 2; return st * 1024 + (ob ^ (((ob >> 9) & 1) << 5)); }
__host__ __device__ __forceinline__ void stage_rc(int b, int& R, int& C) { const int st = b / 1024, sb = b % 1024, swz = sb ^ (((sb >> 9) & 1) << 5); R = (st >> 1) * 16 + swz / 64; C = (st & 1) * 32 + (swz % 64) / 2; }
__host__ __device__ __forceinline__ int perm32(int rho) { const int n = rho >> 4, i = rho & 15; return 8 * (i >> 2) + 4 * n + (i & 3); }

struct Unit { int pm, pn; };
struct Gemm { const bf16_t* A; const bf16_t* Bt; int M, N, K; };

struct StaticOrder {
    int nM, nN, nwg, G, c;
    __host__ __device__ void init(int M, int N, int G_, int c_) { nM = M / BM; nN = N / BM; nwg = nM * nN; G = G_; c = c_; }
    __host__ __device__ bool next(int i, Unit& u) const {
        const long L = (long)i * G + c; if (L >= nwg) return false;
        int wgid = (int)L; { const int q = nwg / NXCD, r = nwg % NXCD, xcd = wgid % NXCD, off = wgid / NXCD; wgid = (xcd < r ? xcd * (q + 1) : r * (q + 1) + (xcd - r) * q) + off; }
        const int nig = WGM * nN, gid = wgid / nig, fm = gid * WGM, gsz = (nM - fm) < WGM ? (nM - fm) : WGM;
        u.pm = fm + ((wgid % nig) % gsz); u.pn = (wgid % nig) / gsz; return true;
    }
    __device__ __forceinline__ void a_ready(const Unit&) const {}
    __device__ __forceinline__ void done(const Unit&) const {}
};
template <class Epi, class Sched>
__device__ __forceinline__ void gemm_phase(PG8_LAS unsigned char* lds, const Gemm g, const Sched& S, const Epi& E, const int wv) {
    const int wid = wv, lane = lane_id(), tid = wv * 64 + lane, wr = wid >> 2, wc = wid & 3, fr = lane & 15, fq = lane >> 4;
    const int K = g.K, nt = K / BK;
    unsigned voffA[2], voffB[2];
#pragma unroll
    for (int i = 0; i < 2; ++i) { int R, C; stage_rc(tid * 16 + i * 8192, R, C); const int Rb = Epi::PERM ? ((R & ~31) + perm32(R & 31)) : R;
        voffA[i] = (unsigned)(R * K + C) * 2u; voffB[i] = (unsigned)(Rb * K + C) * 2u; }
    const size_t kstep = (size_t)(BK * 2);
    const size_t hstep = (size_t)HALF * K * 2;
    const size_t tstep = 2 * hstep;
    const unsigned ldsw = (unsigned)wid * 1024u;
    const int aoff = lds_byte(wr * 64 + fr, fq * 8), boff = lds_byte(wc * 32 + fr, fq * 8);
#define PG8_SA(b, h) (((b) * 2 + (h)) * HTB)
#define PG8_SB(b, h) ((4 + (b) * 2 + (h)) * HTB)
#define PG8_STAGE(bufoff, gbase, voff) do { _Pragma("unroll") for (int _i = 0; _i < 2; ++_i) \
        __builtin_amdgcn_global_load_lds((const unsigned*)((const char*)(gbase) + (voff)[_i]), (PG8_LAS unsigned*)(lds + (bufoff) + ldsw + _i * 8192), 16, 0, 0); } while (0)
#define PG8_LDA(dst, b, h) do { _Pragma("unroll") for (int m = 0; m < 4; ++m) _Pragma("unroll") for (int k = 0; k < 2; ++k) dst[m][k] = *(const PG8_LAS bf16x8*)(lds + PG8_SA(b, h) + aoff + m * 2048 + k * 1024); } while (0)
#define PG8_LDB(dst, b, h) do { _Pragma("unroll") for (int n = 0; n < 2; ++n) _Pragma("unroll") for (int k = 0; k < 2; ++k) dst[n][k] = *(const PG8_LAS bf16x8*)(lds + PG8_SB(b, h) + boff + n * 2048 + k * 1024); } while (0)
#define PG8_MMA(ai, bj, At, Bt) do { __builtin_amdgcn_s_setprio(1); _Pragma("unroll") for (int m = 0; m < 4; ++m) _Pragma("unroll") for (int n = 0; n < 2; ++n) _Pragma("unroll") for (int k = 0; k < 2; ++k) \
        acc[ai][bj][m][n] = __builtin_amdgcn_mfma_f32_16x16x32_bf16(Bt[n][k], At[m][k], acc[ai][bj][m][n], 0, 0, 0); __builtin_amdgcn_s_setprio(0); } while (0)
#define PG8_WAIT_V(n) asm volatile("s_waitcnt vmcnt(" #n ")" ::: "memory")
#define PG8_WAIT_L(n) asm volatile("s_waitcnt lgkmcnt(" #n ")" ::: "memory")
#define PG8_BAR __builtin_amdgcn_s_barrier()
#define PG8_SCHED __builtin_amdgcn_sched_barrier(0)
    Unit cur, nxt; int ui = 0;
    if (!S.next(0, cur)) return;
    f32x4 acc[2][2][4][2];
#pragma unroll
    for (int a = 0; a < 2; ++a)
#pragma unroll
        for (int b = 0; b < 2; ++b)
#pragma unroll
            for (int m = 0; m < 4; ++m)
#pragma unroll
                for (int n = 0; n < 2; ++n) acc[a][b][m][n] = (f32x4){0.f, 0.f, 0.f, 0.f};
    bf16x8 At[4][2], B0[2][2], B1[2][2];
    const char* cA = (const char*)g.A + (size_t)cur.pm * tstep; const char* cB = (const char*)g.Bt + (size_t)cur.pn * tstep;
    S.a_ready(cur);
    PG8_STAGE(PG8_SB(0, 0), cB, voffB); PG8_STAGE(PG8_SA(0, 0), cA, voffA); PG8_STAGE(PG8_SB(0, 1), cB + hstep, voffB); PG8_STAGE(PG8_SA(0, 1), cA + hstep, voffA);
    if (wr == 1) PG8_BAR;
    PG8_WAIT_V(4); PG8_BAR;
    PG8_STAGE(PG8_SB(1, 0), cB + kstep, voffB); PG8_STAGE(PG8_SA(1, 0), cA + kstep, voffA); PG8_STAGE(PG8_SB(1, 1), cB + hstep + kstep, voffB);
    PG8_WAIT_V(6); PG8_BAR;
    for (;;) {
        const bool has_next = S.next(ui + 1, nxt);
        const char* nA = has_next ? (const char*)g.A + (size_t)nxt.pm * tstep : cA; const char* nB = has_next ? (const char*)g.Bt + (size_t)nxt.pn * tstep : cB;
        for (int t = 0; t < nt; t += 2) {
            const bool last = (t == nt - 2);
            const char* a1 = cA + (size_t)(t + 1) * kstep;
            const char* a2 = last ? nA : cA + (size_t)(t + 2) * kstep; const char* b2 = last ? nB : cB + (size_t)(t + 2) * kstep;
            const char* a3 = a2 + kstep; const char* b3 = b2 + kstep;
            if (last && has_next) S.a_ready(nxt);
            PG8_LDB(B0, 0, 0); PG8_SCHED; PG8_LDA(At, 0, 0); PG8_STAGE(PG8_SA(1, 1), a1 + hstep, voffA);
            PG8_WAIT_L(8); PG8_BAR; PG8_WAIT_L(0); PG8_MMA(0, 0, At, B0); PG8_BAR; PG8_SCHED;
            PG8_LDB(B1, 0, 1); PG8_STAGE(PG8_SB(0, 0), b2, voffB);
            PG8_BAR; PG8_WAIT_L(0); PG8_MMA(0, 1, At, B1); PG8_BAR;
            PG8_LDA(At, 0, 1); PG8_STAGE(PG8_SA(0, 0), a2, voffA);
            PG8_BAR; PG8_WAIT_L(0); PG8_MMA(1, 0, At, B0); PG8_BAR; PG8_SCHED;
            PG8_STAGE(PG8_SB(0, 1), b2 + hstep, voffB);
            PG8_WAIT_V(6); PG8_BAR; PG8_MMA(1, 1, At, B1); PG8_BAR;
            PG8_LDB(B0, 1, 0); PG8_SCHED; PG8_LDA(At, 1, 0); PG8_STAGE(PG8_SA(0, 1), a2 + hstep, voffA);
            PG8_WAIT_L(8); PG8_BAR; PG8_WAIT_L(0); PG8_MMA(0, 0, At, B0); PG8_BAR; PG8_SCHED;
            PG8_LDB(B1, 1, 1); PG8_STAGE(PG8_SB(1, 0), b3, voffB);
            PG8_BAR; PG8_WAIT_L(0); PG8_MMA(0, 1, At, B1); PG8_BAR;
            PG8_LDA(At, 1, 1); PG8_STAGE(PG8_SA(1, 0), a3, voffA);
            PG8_BAR; PG8_WAIT_L(0); PG8_MMA(1, 0, At, B0); PG8_BAR; PG8_SCHED;
            PG8_STAGE(PG8_SB(1, 1), b3 + hstep, voffB);
            PG8_WAIT_V(6); PG8_BAR; PG8_MMA(1, 1, At, B1); PG8_BAR;
        }
        if constexpr (!Epi::AFTER_DRAIN) { E(acc, cur, wr, wc, fr, fq); S.done(cur); }
        if (!has_next) break;
#pragma unroll
        for (int a = 0; a < 2; ++a)
#pragma unroll
            for (int b = 0; b < 2; ++b)
#pragma unroll
                for (int m = 0; m < 4; ++m)
#pragma unroll
                    for (int n = 0; n < 2; ++n) acc[a][b][m][n] = (f32x4){0.f, 0.f, 0.f, 0.f};
        cur = nxt; cA = nA; cB = nB; ++ui;
    }
    PG8_WAIT_V(0);
    if (wr == 0) PG8_BAR;
    PG8_BAR;
    if constexpr (Epi::AFTER_DRAIN) { E.fused(acc, cur, wr, wc, fr, fq, lds, wid, lane); S.done(cur); }
#undef PG8_SA
#undef PG8_SB
#undef PG8_STAGE
#undef PG8_LDA
#undef PG8_LDB
#undef PG8_MMA
#undef PG8_WAIT_V
#undef PG8_WAIT_L
#undef PG8_BAR
#undef PG8_SCHED
}
}
using pg8::bf16_t; using pg8::bf16x8; using pg8::f32x4; using pg8::u32x4; using pg8::Unit;
#define LAS __attribute__((address_space(3)))
typedef unsigned u32x2 __attribute__((ext_vector_type(2)));

constexpr int T_ = 8192, D_ = 2048, NP_ = 6144, NPF_ = 6152, DFF_ = 5632, NUP_ = 11264, DPLE_ = 256, SEQ_ = 2048;
constexpr float EPS_ = 1e-6f;
constexpr size_t MiB = (size_t)1 << 20;
constexpr size_t WS_SMALL = 0, WS_WPG = 3 * MiB, WS_WDOWN = 11 * MiB, WS_PP = 33 * MiB,
                 WS_PROJ = 65 * MiB, WS_WOUT = 161 * MiB, WS_WPP = 169 * MiB, WS_PB = 170 * MiB,
                 WS_UP = 65 * MiB, WS_X2B = 65 * MiB, WS_WUP = 241 * MiB, WS_X1B = 285 * MiB, WS_WIN = 285 * MiB,
                 WS_XB = 317 * MiB, WS_Y = 285 * MiB, WS_ACT = 241 * MiB, WS_X3B = 65 * MiB, WS_X2B2 = 100 * MiB, WS_END = 349 * MiB;
constexpr size_t OUT_PB = (size_t)T_ * D_, OUT_WPP = (size_t)T_ * D_ + (size_t)T_ * DPLE_;
constexpr size_t SM_RSTD0 = 0, SM_GATES = 64 * 1024, SM_ACUM = 320 * 1024, SM_MRUN = 448 * 1024, SM_BCUM = 576 * 1024, SM_CNT = 704 * 1024, SM_BAR = 960 * 1024, SM_SSA = 1 * MiB, SM_SSB = 2 * MiB;
constexpr int LDS_BYTES = 131072 + 1024;

struct Params { const float* in[18]; float* out; unsigned char* ws; int ph_lo, ph_hi; };

__device__ __forceinline__ unsigned pk_bf16(float lo, float hi) { unsigned r; asm("v_cvt_pk_bf16_f32 %0, %1, %2" : "=v"(r) : "v"(lo), "v"(hi)); return r; }
__device__ __forceinline__ float bflo(unsigned w) { return __uint_as_float(w << 16); }
__device__ __forceinline__ float bfhi(unsigned w) { return __uint_as_float(w & 0xffff0000u); }
__device__ __forceinline__ float sigm(float x) { return __builtin_amdgcn_rcpf(1.0f + __expf(-x)); }
__device__ __forceinline__ float wave_sum(float v) {
#pragma unroll
    for (int o = 32; o; o >>= 1) v += __shfl_xor(v, o);
    return v;
}
__device__ __forceinline__ void unpack8(const u32x4 w, float (&f)[8]) {
    f[0] = bflo(w.x); f[1] = bfhi(w.x); f[2] = bflo(w.y); f[3] = bfhi(w.y); f[4] = bflo(w.z); f[5] = bfhi(w.z); f[6] = bflo(w.w); f[7] = bfhi(w.w);
}
__device__ __forceinline__ u32x4 pack8(const float (&f)[8]) { u32x4 w; w.x = pk_bf16(f[0], f[1]); w.y = pk_bf16(f[2], f[3]); w.z = pk_bf16(f[4], f[5]); w.w = pk_bf16(f[6], f[7]); return w; }

struct TileDesc { const float* src; bf16_t* dst; const float* gk; int N, ldt, k0, n0; float cs; };
__device__ __forceinline__ TileDesc tile_desc(const Params& p, int l) {
    constexpr int NT_IN = 32 * 96, NT_PP = 4 * 32, NT_OUT = 32 * 32, NT_UP = 32 * 176, NT_DOWN = 88 * 32;
    unsigned char* ws = p.ws; TileDesc d; d.cs = 1.0f; d.gk = nullptr; int ntn;
    if (l < NT_IN) { ntn = 96; d.src = p.in[3]; d.N = NPF_; d.dst = (bf16_t*)(ws + WS_WIN); d.ldt = D_; d.gk = p.in[2]; const int nt = l % 96; if (nt >= 48 && nt < 56) d.cs = 0.08838834764831845f; }
    else if ((l -= NT_IN) < NT_PP) { ntn = 32; d.src = p.in[16]; d.N = D_; d.dst = (bf16_t*)p.out + OUT_WPP; d.ldt = DPLE_; }
    else if ((l -= NT_PP) < NT_OUT) { ntn = 32; d.src = p.in[8]; d.N = D_; d.dst = (bf16_t*)(ws + WS_WOUT); d.ldt = D_; }
    else if ((l -= NT_OUT) < NT_UP) { ntn = 176; d.src = p.in[10]; d.N = NUP_; d.dst = (bf16_t*)(ws + WS_WUP); d.ldt = D_; d.gk = p.in[9]; }
    else if ((l -= NT_UP) < NT_DOWN) { ntn = 32; d.src = p.in[13]; d.N = D_; d.dst = (bf16_t*)(ws + WS_WDOWN); d.ldt = DFF_; }
    else { l -= NT_DOWN; ntn = 32; d.src = p.in[15]; d.N = D_; d.dst = (bf16_t*)(ws + WS_WPG); d.ldt = D_; d.gk = p.in[14]; }
    d.n0 = (l % ntn) * 64; d.k0 = (l / ntn) * 64; return d;
}

constexpr int NT_EARLY = 32 * 96 + 4 * 32 + 32 * 32 + 32 * 176;
constexpr int NT_ALL = NT_EARLY + 88 * 32 + 32 * 32;
__device__ void convert_tiles(const Params& p, LAS unsigned char* lds, const int first, const int last, const int worker, const int nworkers, const int wv) {
    const int tid = TID_X;
    const int n4 = tid & 15, kp = tid >> 4, r = tid >> 3, c = tid & 7;
    for (int i4 = first + worker * 4; i4 < last; i4 += nworkers * 4) {
        f32x4 a[4], b[4]; float g0[4], g1[4];
#pragma unroll
        for (int u = 0; u < 4; ++u) {
            const TileDesc d = tile_desc(p, i4 + u);
            const float* src = d.src + (size_t)(d.k0 + 2 * kp) * d.N + d.n0 + 4 * n4;
            a[u] = __builtin_nontemporal_load((const f32x4*)src); b[u] = __builtin_nontemporal_load((const f32x4*)(src + d.N));
            g0[u] = d.cs; g1[u] = d.cs;
            if (d.gk) { g0[u] *= d.gk[d.k0 + 2 * kp]; g1[u] *= d.gk[d.k0 + 2 * kp + 1]; }
        }
        __syncthreads();
#pragma unroll
        for (int u = 0; u < 4; ++u) {
            LAS unsigned* l32 = (LAS unsigned*)(lds + u * 8448);
#pragma unroll
            for (int j = 0; j < 4; ++j) l32[(4 * n4 + j) * 33 + kp] = pk_bf16(a[u][j] * g0[u], b[u][j] * g1[u]);
        }
        __syncthreads();
#pragma unroll
        for (int u = 0; u < 4; ++u) {
            const TileDesc d = tile_desc(p, i4 + u);
            LAS unsigned* l32 = (LAS unsigned*)(lds + u * 8448);
            u32x4 o; o.x = l32[r * 33 + 4 * c]; o.y = l32[r * 33 + 4 * c + 1]; o.z = l32[r * 33 + 4 * c + 2]; o.w = l32[r * 33 + 4 * c + 3];
            *(u32x4*)(d.dst + (size_t)(d.n0 + r) * d.ldt + d.k0 + 8 * c) = o;
        }
    }
}

__device__ void phase_prep(const Params& p, LAS unsigned char* lds, const int wv) {
    const int wid = wv, lane = lane_id(), tid = wv * 64 + lane;
    unsigned char* ws = p.ws;
    convert_tiles(p, lds, 0, NT_EARLY, blockIdx.x, gridDim.x, wv);
    __syncthreads();
    LAS float* wg = (LAS float*)(lds + 32768);
    for (int i = tid; i < 2048 * 2; i += 512) {
        const int k = i >> 1, hf = i & 1;
        f32x4 v = *(const f32x4*)(p.in[3] + (size_t)k * NPF_ + NP_ + 4 * hf);
        const float g = p.in[2][k];
#pragma unroll
        for (int j = 0; j < 4; ++j) wg[(4 * hf + j) * 2048 + k] = v[j] * g;
    }
    __syncthreads();
    bf16_t* xb = (bf16_t*)(ws + WS_XB);
    float* rstd0 = (float*)(ws + WS_SMALL + SM_RSTD0);
    float* gates = (float*)(ws + WS_SMALL + SM_GATES);
    for (int row = blockIdx.x * 8 + wid; row < T_; row += gridDim.x * 8) {
        const float* xr = p.in[0] + (size_t)row * D_;
        float ss = 0.f, dots[8];
#pragma unroll
        for (int j = 0; j < 8; ++j) dots[j] = 0.f;
#pragma unroll
        for (int i = 0; i < 8; ++i) {
            const int k = (i * 64 + lane) * 4;
            const f32x4 v = __builtin_nontemporal_load((const f32x4*)(xr + k));
            ss += v.x * v.x + v.y * v.y + v.z * v.z + v.w * v.w;
            u32x2 o; o.x = pk_bf16(v.x, v.y); o.y = pk_bf16(v.z, v.w);
            *(u32x2*)(xb + (size_t)row * D_ + k) = o;
#pragma unroll
            for (int j = 0; j < 8; ++j) { const f32x4 w = *(const LAS f32x4*)(wg + j * 2048 + k); dots[j] += v.x * w.x + v.y * w.y + v.z * w.z + v.w * w.w; }
        }
        ss = wave_sum(ss);
#pragma unroll
        for (int j = 0; j < 8; ++j) dots[j] = wave_sum(dots[j]);
        const float rs = rsqrtf(ss * (1.0f / D_) + EPS_);
        if (lane == 0) rstd0[row] = rs;
        if (lane < 8) {
            float d = dots[0];
#pragma unroll
            for (int j = 1; j < 8; ++j) d = (lane == j) ? dots[j] : d;
            const float bias = (lane < 4) ? p.in[4][lane & 3] : p.in[5][lane & 3];
            gates[(size_t)row * 8 + lane] = rs * d + bias;
        }
    }
    {
        bf16_t* pb = (bf16_t*)p.out + OUT_PB;
        const size_t n4 = (size_t)T_ * DPLE_ / 4;
        for (size_t i = (size_t)blockIdx.x * 512 + tid; i < n4; i += (size_t)gridDim.x * 512) {
            const f32x4 v = __builtin_nontemporal_load((const f32x4*)(p.in[1] + i * 4));
            u32x2 o; o.x = pk_bf16(v.x, v.y); o.y = pk_bf16(v.z, v.w);
            *(u32x2*)(pb + i * 4) = o;
        }
    }
}

#define DPPF(old, x, ctrl, rmask) __builtin_bit_cast(float, __builtin_amdgcn_update_dpp(__builtin_bit_cast(int, (float)(old)), __builtin_bit_cast(int, (float)(x)), ctrl, rmask, 0xf, false))
__device__ __forceinline__ float wave_scan_add(float v) {
    v += DPPF(0.f, v, 0x111, 0xf); v += DPPF(0.f, v, 0x112, 0xf); v += DPPF(0.f, v, 0x114, 0xf); v += DPPF(0.f, v, 0x118, 0xf);
    v += DPPF(0.f, v, 0x142, 0xa); v += DPPF(0.f, v, 0x143, 0xc);
    return v;
}
__device__ __forceinline__ float wave_scan_max(float v) {
    const float ninf = -__builtin_inff();
    v = fmaxf(v, DPPF(ninf, v, 0x111, 0xf)); v = fmaxf(v, DPPF(ninf, v, 0x112, 0xf)); v = fmaxf(v, DPPF(ninf, v, 0x114, 0xf)); v = fmaxf(v, DPPF(ninf, v, 0x118, 0xf));
    v = fmaxf(v, DPPF(ninf, v, 0x142, 0xa)); v = fmaxf(v, DPPF(ninf, v, 0x143, 0xc));
    return v;
}
__device__ void scan_gates(const float* gates, float* acum, float* mrun, float* bcum, int bh, int lane) {
    const int batch = bh >> 2, h = bh & 3;
    float fgv[32], igv[32];
#pragma unroll
    for (int r = 0; r < 32; ++r) { const size_t t = (size_t)batch * SEQ_ + r * 64 + lane; fgv[r] = gates[t * 8 + 4 + h]; igv[r] = gates[t * 8 + h]; }
    float carryB = 0.f, carryM = 0.f;
#pragma unroll
    for (int r = 0; r < 32; ++r) {
        const int s = r * 64 + lane;
        const float fg = fgv[r], ig = igv[r];
        const float lf = -(fmaxf(-fg, 0.f) + log1pf(expf(-fabsf(fg))));
        const float B = carryB + wave_scan_add(lf);
        const float a = ig - B;
        const float M = fmaxf(carryM, wave_scan_max(a));
        acum[bh * SEQ_ + s] = a; mrun[bh * SEQ_ + s] = M; bcum[bh * SEQ_ + s] = B;
        carryB = __builtin_bit_cast(float, __builtin_amdgcn_readlane(__builtin_bit_cast(int, B), 63));
        carryM = __builtin_bit_cast(float, __builtin_amdgcn_readlane(__builtin_bit_cast(int, M), 63));
    }
}

#define SCHED_FENCE() __builtin_amdgcn_sched_barrier(0)
__device__ __forceinline__ void store_bf16_rows(const f32x4 (&acc)[2][2][4][2], bf16_t* O, int ldc, int row0, int col0, const float (&rs)[2][4]) {
#pragma unroll
    for (int ai = 0; ai < 2; ++ai)
#pragma unroll
        for (int m = 0; m < 4; ++m) {
            bf16_t* rowp = O + (size_t)(row0 + ai * 128 + m * 16) * ldc + col0;
            const float r = rs[ai][m];
#pragma unroll
            for (int bj = 0; bj < 2; ++bj) {
                const f32x4 v0 = acc[ai][bj][m][0] * r, v1 = acc[ai][bj][m][1] * r;
                u32x4 w; w.x = pk_bf16(v0[0], v0[1]); w.y = pk_bf16(v0[2], v0[3]); w.z = pk_bf16(v1[0], v1[1]); w.w = pk_bf16(v1[2], v1[3]);
                *(u32x4*)(rowp + bj * 128) = w;
            }
        }
}
struct EpiBf16Scale {
    static constexpr bool PERM = true, AFTER_DRAIN = false;
    bf16_t* O; int ldc; const float* rowscale;
    __device__ __forceinline__ void operator()(const f32x4 (&acc)[2][2][4][2], const Unit& u, int wr, int wc, int fr, int fq) const {
        const int row0 = u.pm * 256 + wr * 64 + fr, col0 = u.pn * 256 + wc * 32 + 8 * fq;
        float rs[2][4];
#pragma unroll
        for (int ai = 0; ai < 2; ++ai)
#pragma unroll
            for (int m = 0; m < 4; ++m) rs[ai][m] = rowscale ? rowscale[row0 + ai * 128 + m * 16] : 1.0f;
        SCHED_FENCE();
        store_bf16_rows(acc, O, ldc, row0, col0, rs);
    }
};
__device__ __forceinline__ void rstd_rows(const float* ss, int row0, int fq, float (&rs)[2][4]) {
    f32x4 a[2][4], b[2][4];
#pragma unroll
    for (int ai = 0; ai < 2; ++ai)
#pragma unroll
        for (int m = 0; m < 4; ++m) { const float* q = ss + (size_t)(row0 + ai * 128 + m * 16) * 32 + 8 * fq; a[ai][m] = *(const f32x4*)q; b[ai][m] = *(const f32x4*)(q + 4); }
    SCHED_FENCE();
#pragma unroll
    for (int ai = 0; ai < 2; ++ai)
#pragma unroll
        for (int m = 0; m < 4; ++m) {
            const f32x4 x = a[ai][m], y = b[ai][m];
            float t = ((x.x + x.y) + (x.z + x.w)) + ((y.x + y.y) + (y.z + y.w));
            t += __shfl_xor(t, 16); t += __shfl_xor(t, 32);
            rs[ai][m] = rsqrtf(t * (1.0f / D_) + EPS_);
        }
}
struct EpiBf16Norm {
    static constexpr bool PERM = true, AFTER_DRAIN = false;
    bf16_t* O; int ldc; const float* ss;
    __device__ __forceinline__ void operator()(const f32x4 (&acc)[2][2][4][2], const Unit& u, int wr, int wc, int fr, int fq) const {
        const int row0 = u.pm * 256 + wr * 64 + fr, col0 = u.pn * 256 + wc * 32 + 8 * fq;
        float rs[2][4];
        rstd_rows(ss, row0, fq, rs);
        SCHED_FENCE();
        store_bf16_rows(acc, O, ldc, row0, col0, rs);
    }
};
struct EpiResidBf {
    static constexpr bool PERM = true, AFTER_DRAIN = false;
    const bf16_t* base; bf16_t* ob; float* ssout;
    __device__ __forceinline__ void operator()(const f32x4 (&acc)[2][2][4][2], const Unit& u, int wr, int wc, int fr, int fq) const {
        const int row0 = u.pm * 256 + wr * 64 + fr, col0 = u.pn * 256 + wc * 32 + 8 * fq;
        u32x4 r[4][2];
#define ER_LOAD(q) do { const size_t off_ = (size_t)(row0 + ((q) >> 2) * 128 + ((q) & 3) * 16) * D_ + col0; r[(q) & 3][0] = *(const u32x4*)(base + off_); r[(q) & 3][1] = *(const u32x4*)(base + off_ + 128); } while (0)
        ER_LOAD(0); ER_LOAD(1); ER_LOAD(2);
#pragma unroll
        for (int q = 0; q < 8; ++q) {
            const int ai = q >> 2, m = q & 3;
            if (q + 3 < 8) ER_LOAD(q + 3);
            SCHED_FENCE();
            const int row = row0 + ai * 128 + m * 16;
            const size_t off = (size_t)row * D_ + col0;
            float s = 0.f;
#pragma unroll
            for (int bj = 0; bj < 2; ++bj) {
                float f[8]; unpack8(r[q & 3][bj], f);
                const f32x4 v0 = acc[ai][bj][m][0] + (f32x4){f[0], f[1], f[2], f[3]}, v1 = acc[ai][bj][m][1] + (f32x4){f[4], f[5], f[6], f[7]};
                u32x4 w; w.x = pk_bf16(v0[0], v0[1]); w.y = pk_bf16(v0[2], v0[3]); w.z = pk_bf16(v1[0], v1[1]); w.w = pk_bf16(v1[2], v1[3]);
                *(u32x4*)(ob + off + bj * 128) = w;
                s += (v0[0] * v0[0] + v0[1] * v0[1]) + (v0[2] * v0[2] + v0[3] * v0[3]) + (v1[0] * v1[0] + v1[1] * v1[1]) + (v1[2] * v1[2] + v1[3] * v1[3]);
            }
            s += __shfl_xor(s, 16); s += __shfl_xor(s, 32);
            if (fq == 0) ssout[(size_t)row * 32 + u.pn * 4 + wc] = s;
            SCHED_FENCE();
        }
#undef ER_LOAD
    }
};
struct EpiPleGateBf {
    static constexpr bool PERM = true, AFTER_DRAIN = false;
    const bf16_t* base; bf16_t* ob; const bf16_t* pp; const float* ssin; float* ssout;
    __device__ __forceinline__ void operator()(const f32x4 (&acc)[2][2][4][2], const Unit& u, int wr, int wc, int fr, int fq) const {
        const int row0 = u.pm * 256 + wr * 64 + fr, col0 = u.pn * 256 + wc * 32 + 8 * fq;
        float rs[2][4];
        rstd_rows(ssin, row0, fq, rs);
        u32x4 r[2][2], pw[2][2];
#define EP_LOAD(slot, q) do { const size_t off_ = (size_t)(row0 + ((q) >> 2) * 128 + ((q) & 3) * 16) * D_ + col0; \
            r[slot][0] = *(const u32x4*)(base + off_); r[slot][1] = *(const u32x4*)(base + off_ + 128); \
            pw[slot][0] = *(const u32x4*)(pp + off_); pw[slot][1] = *(const u32x4*)(pp + off_ + 128); } while (0)
        EP_LOAD(0, 0);
#pragma unroll
        for (int q = 0; q < 8; ++q) {
            const int ai = q >> 2, m = q & 3, sl = q & 1;
            if (q + 1 < 8) EP_LOAD((q + 1) & 1, q + 1);
            SCHED_FENCE();
            const int row = row0 + ai * 128 + m * 16;
            const size_t off = (size_t)row * D_ + col0;
            const float rsv = rs[ai][m];
            float s = 0.f;
#pragma unroll
            for (int bj = 0; bj < 2; ++bj) {
                float pf[8], xf[8]; unpack8(pw[sl][bj], pf); unpack8(r[sl][bj], xf);
                f32x4 v0, v1;
#pragma unroll
                for (int j = 0; j < 4; ++j) { v0[j] = xf[j] + sigm(acc[ai][bj][m][0][j] * rsv) * pf[j]; v1[j] = xf[4 + j] + sigm(acc[ai][bj][m][1][j] * rsv) * pf[4 + j]; }
                u32x4 w; w.x = pk_bf16(v0[0], v0[1]); w.y = pk_bf16(v0[2], v0[3]); w.z = pk_bf16(v1[0], v1[1]); w.w = pk_bf16(v1[2], v1[3]);
                *(u32x4*)(ob + off + bj * 128) = w;
                s += (v0[0] * v0[0] + v0[1] * v0[1]) + (v0[2] * v0[2] + v0[3] * v0[3]) + (v1[0] * v1[0] + v1[1] * v1[1]) + (v1[2] * v1[2] + v1[3] * v1[3]);
            }
            s += __shfl_xor(s, 16); s += __shfl_xor(s, 32);
            if (fq == 0) ssout[(size_t)row * 32 + u.pn * 4 + wc] = s;
            SCHED_FENCE();
        }
#undef EP_LOAD
    }
};

struct EpiPleFinal {
    static constexpr bool PERM = true, AFTER_DRAIN = true, APERM = false;
    const bf16_t* base; const bf16_t* pp; const float* ssin; float* ssx; unsigned* cnt; const float* gf; float* out;
    __device__ __forceinline__ void fused(const f32x4 (&acc)[2][2][4][2], const Unit& u, int wr, int wc, int fr, int fq, LAS unsigned char*, int, int) const {
        const int row0 = u.pm * 256 + wr * 64 + fr, col0 = u.pn * 256 + wc * 32 + 8 * fq;
        float rs[2][4];
        rstd_rows(ssin, row0, fq, rs);
        u32x4 xk[8][2];
        u32x4 r[2][2], pw[2][2];
#define EP_LOAD(slot, q) do { const size_t off_ = (size_t)(row0 + ((q) >> 2) * 128 + ((q) & 3) * 16) * D_ + col0; \
            r[slot][0] = *(const u32x4*)(base + off_); r[slot][1] = *(const u32x4*)(base + off_ + 128); \
            pw[slot][0] = *(const u32x4*)(pp + off_); pw[slot][1] = *(const u32x4*)(pp + off_ + 128); } while (0)
        EP_LOAD(0, 0);
#pragma unroll
        for (int q = 0; q < 8; ++q) {
            const int ai = q >> 2, m = q & 3, sl = q & 1;
            if (q + 1 < 8) EP_LOAD((q + 1) & 1, q + 1);
            SCHED_FENCE();
            const int row = row0 + ai * 128 + m * 16;
            const float rsv = rs[ai][m];
            float s = 0.f;
#pragma unroll
            for (int bj = 0; bj < 2; ++bj) {
                float pf[8], xf[8]; unpack8(pw[sl][bj], pf); unpack8(r[sl][bj], xf);
                f32x4 v0, v1;
#pragma unroll
                for (int j = 0; j < 4; ++j) { v0[j] = xf[j] + sigm(acc[ai][bj][m][0][j] * rsv) * pf[j]; v1[j] = xf[4 + j] + sigm(acc[ai][bj][m][1][j] * rsv) * pf[4 + j]; }
                u32x4 w; w.x = pk_bf16(v0[0], v0[1]); w.y = pk_bf16(v0[2], v0[3]); w.z = pk_bf16(v1[0], v1[1]); w.w = pk_bf16(v1[2], v1[3]);
                xk[q][bj] = w;
                s += (v0[0] * v0[0] + v0[1] * v0[1]) + (v0[2] * v0[2] + v0[3] * v0[3]) + (v1[0] * v1[0] + v1[1] * v1[1]) + (v1[2] * v1[2] + v1[3] * v1[3]);
            }
            s += __shfl_xor(s, 16); s += __shfl_xor(s, 32);
            if (fq == 0) __hip_atomic_store(ssx + (size_t)row * 32 + u.pn * 4 + wc, s, __ATOMIC_RELAXED, __HIP_MEMORY_SCOPE_AGENT);
            SCHED_FENCE();
        }
#undef EP_LOAD
        asm volatile("s_waitcnt vmcnt(0)" ::: "memory");
        unsigned* const c = cnt + 64 * u.pm;
        if (fr == 0 && fq == 0) __hip_atomic_fetch_add(c, 1u, __ATOMIC_RELAXED, __HIP_MEMORY_SCOPE_AGENT);
        if (wr == 0 && wc == 0) {
            for (unsigned spins = 0; spins < (1u << 22); ++spins) {
                if ((unsigned)__builtin_amdgcn_readfirstlane((int)__hip_atomic_load(c, __ATOMIC_RELAXED, __HIP_MEMORY_SCOPE_AGENT)) >= 64u) break;
                __builtin_amdgcn_s_sleep(1);
            }
            __builtin_amdgcn_fence(__ATOMIC_ACQUIRE, "agent");
            asm volatile("s_waitcnt vmcnt(0)" ::: "memory");
        }
        __builtin_amdgcn_s_barrier();
        asm volatile("" ::: "memory");
        float rs3[2][4];
        rstd_rows(ssx, row0, fq, rs3);
        f32x4 gfv[2][2];
#pragma unroll
        for (int bj = 0; bj < 2; ++bj) { gfv[bj][0] = *(const f32x4*)(gf + col0 + bj * 128); gfv[bj][1] = *(const f32x4*)(gf + col0 + bj * 128 + 4); }
#pragma unroll
        for (int q = 0; q < 8; ++q) {
            const int ai = q >> 2, m = q & 3;
            const size_t off = (size_t)(row0 + ai * 128 + m * 16) * D_ + col0;
            const float rv = rs3[ai][m];
#pragma unroll
            for (int bj = 0; bj < 2; ++bj) {
                float f[8]; unpack8(xk[q][bj], f);
                *(f32x4*)(out + off + bj * 128) = (f32x4){f[0], f[1], f[2], f[3]} * rv * gfv[bj][0];
                *(f32x4*)(out + off + bj * 128 + 4) = (f32x4){f[4], f[5], f[6], f[7]} * rv * gfv[bj][1];
            }
        }
    }
};

__device__ void phase_convgroup(const Params& p, const int wv) {
    const bf16_t* proj = (const bf16_t*)(p.ws + WS_PROJ);
    bf16_t* y = (bf16_t*)(p.ws + WS_Y);
    const float* cw = p.in[6];
    for (int it = blockIdx.x * 512 + TID_X; it < (T_ / 8) * 128; it += gridDim.x * 512) {
        const int cc = it & 127, run = it >> 7, c = cc * 8, t0 = run * 8;
        float w0[8], w1[8], w2[8], p2[8], p1[8];
#pragma unroll
        for (int j = 0; j < 8; ++j) { w0[j] = cw[c + j]; w1[j] = cw[1024 + c + j]; w2[j] = cw[2048 + c + j]; p2[j] = 0.f; p1[j] = 0.f; }
        if ((t0 & (SEQ_ - 1)) != 0) {
            float a[8], b[8];
            unpack8(*(const u32x4*)(proj + (size_t)(t0 - 2) * NP_ + 1024 + c), a); unpack8(*(const u32x4*)(proj + (size_t)(t0 - 2) * NP_ + 2048 + c), b);
#pragma unroll
            for (int j = 0; j < 8; ++j) p2[j] = a[j] * b[j];
            unpack8(*(const u32x4*)(proj + (size_t)(t0 - 1) * NP_ + 1024 + c), a); unpack8(*(const u32x4*)(proj + (size_t)(t0 - 1) * NP_ + 2048 + c), b);
#pragma unroll
            for (int j = 0; j < 8; ++j) p1[j] = a[j] * b[j];
        }
#pragma unroll
        for (int dt = 0; dt < 8; ++dt) {
            const size_t ro = (size_t)(t0 + dt) * NP_;
            float gb[8], gc[8], uu[8], o[8];
            unpack8(*(const u32x4*)(proj + ro + c), gb); unpack8(*(const u32x4*)(proj + ro + 1024 + c), gc); unpack8(*(const u32x4*)(proj + ro + 2048 + c), uu);
#pragma unroll
            for (int j = 0; j < 8; ++j) { const float cur = gc[j] * uu[j]; o[j] = gb[j] * (w0[j] * p2[j] + w1[j] * p1[j] + w2[j] * cur); p2[j] = p1[j]; p1[j] = cur; }
            *(u32x4*)(y + (size_t)(t0 + dt) * D_ + c) = pack8(o);
        }
    }
}

constexpr int ML_KOFF = 0, ML_KSZ = 64 * 288, ML_VOFF = 2 * ML_KSZ, ML_VSZ = 256 * 160, ML_AOFF = ML_VOFF + 2 * ML_VSZ, ML_AROFF = ML_AOFF + 512, ML_SSOFF = ML_AROFF + 512;
__device__ __forceinline__ void ml_compute(LAS unsigned char* lds, const int buf, const bool diag, const int tl, const int g, const int tb, const int vh,
                                           const bf16x8 (&qf)[4], const float Mt, const float amax, f32x4 (&oacc)[8], float& den) {
    constexpr int KOFF = ML_KOFF, KSZ = ML_KSZ, VOFF = ML_VOFF, VSZ = ML_VSZ, AOFF = ML_AOFF, AROFF = ML_AROFF;
    LAS unsigned char* const kfb = lds + tl * 288 + g * 16;
    LAS unsigned char* const afb = lds + g * 16;
    LAS unsigned char* const vfb0 = lds + (vh * 128 + tl) * 160 + g * 16;
                u32x4 pf[2];
                f32x4 sa[4];
#pragma unroll
                for (int sh = 0; sh < 2; ++sh) {
                    bf16x8 kf[2][4];
#pragma unroll
                    for (int s2 = 0; s2 < 2; ++s2)
#pragma unroll
                        for (int kk = 0; kk < 4; ++kk) kf[s2][kk] = *(const LAS bf16x8*)(kfb + (KOFF + buf * KSZ + 16 * (2 * sh + s2) * 288 + 64 * kk));
                    SCHED_FENCE();
                    sa[2 * sh] = (f32x4){0.f, 0.f, 0.f, 0.f}; sa[2 * sh + 1] = (f32x4){0.f, 0.f, 0.f, 0.f};
#pragma unroll
                    for (int kk = 0; kk < 4; ++kk)
#pragma unroll
                        for (int s2 = 0; s2 < 2; ++s2) sa[2 * sh + s2] = __builtin_amdgcn_mfma_f32_16x16x32_bf16(kf[s2][kk], qf[kk], sa[2 * sh + s2], 0, 0, 0);
                    SCHED_FENCE();
                }
                bf16x8 vf[4];
#pragma unroll
                for (int i = 0; i < 4; ++i) { const int nb = i >> 1, k2 = i & 1;
                    vf[i] = *(const LAS bf16x8*)(vfb0 + (VOFF + buf * VSZ + nb * 16 * 160 + k2 * 64)); }
                f32x4 a4[4];
                if (!diag) {
#pragma unroll
                    for (int sb = 0; sb < 4; ++sb) a4[sb] = *(const LAS f32x4*)(afb + (AOFF + buf * 256 + 64 * sb));
                    SCHED_FENCE();
                    const float et = __expf(amax - Mt);
#pragma unroll
                    for (int sb = 0; sb < 4; ++sb) {
                        const f32x4 pv = sa[sb] * (a4[sb] * et);
                        den += (pv[0] + pv[1]) + (pv[2] + pv[3]);
                        const unsigned lo = pk_bf16(pv[0], pv[1]), hi = pk_bf16(pv[2], pv[3]);
                        if (sb & 1) { pf[sb >> 1].z = lo; pf[sb >> 1].w = hi; } else { pf[sb >> 1].x = lo; pf[sb >> 1].y = hi; }
                    }
                } else {
#pragma unroll
                    for (int sb = 0; sb < 4; ++sb) a4[sb] = *(const LAS f32x4*)(afb + (AROFF + buf * 256 + 64 * sb));
                    SCHED_FENCE();
#pragma unroll
                    for (int sb = 0; sb < 4; ++sb) {
                        float pv[4];
#pragma unroll
                        for (int j = 0; j < 4; ++j) {
                            float w = __expf(a4[sb][j] - Mt);
                            if ((16 * sb + 4 * g + j) > (tb * 16 + tl)) w = 0.f;
                            pv[j] = sa[sb][j] * w; den += pv[j];
                        }
                        const unsigned lo = pk_bf16(pv[0], pv[1]), hi = pk_bf16(pv[2], pv[3]);
                        if (sb & 1) { pf[sb >> 1].z = lo; pf[sb >> 1].w = hi; } else { pf[sb >> 1].x = lo; pf[sb >> 1].y = hi; }
                    }
                }
                SCHED_FENCE();
                const bf16x8 pb0 = __builtin_bit_cast(bf16x8, pf[0]), pb1 = __builtin_bit_cast(bf16x8, pf[1]);
#pragma unroll
                for (int qd = 0; qd < 4; ++qd) {
#pragma unroll
                    for (int i = 0; i < 4; ++i) oacc[2 * qd + (i >> 1)] = __builtin_amdgcn_mfma_f32_16x16x32_bf16(vf[i], (i & 1) ? pb1 : pb0, oacc[2 * qd + (i >> 1)], 0, 0, 0);
                    if (qd < 3) {
#pragma unroll
                        for (int i = 0; i < 4; ++i) { const int nb = 2 * (qd + 1) + (i >> 1), k2 = i & 1;
                            vf[i] = *(const LAS bf16x8*)(vfb0 + (VOFF + buf * VSZ + nb * 16 * 160 + k2 * 64)); }
                        SCHED_FENCE();
                    }
                }
}

__device__ void phase_mlstm(const Params& p, LAS unsigned char* lds, const int wv) {
    const int wid = wv, lane = lane_id(), tid = wv * 64 + lane, tl = lane & 15, g = lane >> 4, tb = wid & 3, vh = wid >> 2;
    const bf16_t* proj = (const bf16_t*)(p.ws + WS_PROJ);
    bf16_t* y = (bf16_t*)(p.ws + WS_Y);
    const float* acum = (const float*)(p.ws + WS_SMALL + SM_ACUM);
    const float* mrun = (const float*)(p.ws + WS_SMALL + SM_MRUN);
    const float* bcum = (const float*)(p.ws + WS_SMALL + SM_BCUM);
    constexpr int KOFF = ML_KOFF, KSZ = ML_KSZ, VOFF = ML_VOFF, VSZ = ML_VSZ, AOFF = ML_AOFF, AROFF = ML_AROFF, SSOFF = ML_SSOFF;
    for (int pr = blockIdx.x; pr < 256; pr += gridDim.x) {
        const int xx = pr & 7, jj = pr >> 3;
        const int bh = 2 * xx + (jj >> 4), ip = jj & 15, batch = bh >> 2, h = bh & 3;
        for (int which = 0; which < 2; ++which) {
            const int qi = which ? ip : 31 - ip;
            const int trow = batch * SEQ_ + qi * 64 + tb * 16 + tl;
            const int sidx = bh * SEQ_ + qi * 64 + tb * 16 + tl;
            bf16x8 qf[4];
#pragma unroll
            for (int kk = 0; kk < 4; ++kk) qf[kk] = *(const bf16x8*)(proj + (size_t)trow * NP_ + 3072 + h * 128 + 32 * kk + 8 * g);
            const float Mt = mrun[sidx];
            f32x4 oacc[8];
#pragma unroll
            for (int nb = 0; nb < 8; ++nb) oacc[nb] = (f32x4){0.f, 0.f, 0.f, 0.f};
            float den = 0.f;
            u32x4 kreg[2][2], vreg[2][4]; float areg[2] = {0.f, 0.f}, amaxr[2] = {0.f, 0.f};
            const bf16_t* kbase = proj + (size_t)batch * SEQ_ * NP_ + 3584 + h * 128;
            const bf16_t* vbase = proj + (size_t)batch * SEQ_ * NP_ + 4096 + h * 256;
            const unsigned koff = (unsigned)((tid >> 4) * NP_ + (tid & 15) * 8), voff = (unsigned)(4 * (tid & 15) * NP_ + (tid >> 4) * 8);
#define ML_LOAD(kj, S) do { \
                { const bf16_t* kt_ = kbase + (size_t)(kj) * 64 * NP_; const bf16_t* vt_ = vbase + (size_t)(kj) * 64 * NP_; \
                  kreg[S][0] = *(const u32x4*)(kt_ + koff); kreg[S][1] = *(const u32x4*)(kt_ + 32 * NP_ + koff); \
                  _Pragma("unroll") for (int ii = 0; ii < 4; ++ii) vreg[S][ii] = *(const u32x4*)(vt_ + ii * NP_ + voff); } \
                areg[S] = acum[bh * SEQ_ + (kj) * 64 + (tid & 63)]; } while (0)
#define ML_STORE(buf, S) do { \
                _Pragma("unroll") for (int ii = 0; ii < 2; ++ii) { const int ch = tid + 512 * ii; *(LAS u32x4*)(lds + KOFF + (buf) * KSZ + (ch >> 4) * 288 + (ch & 15) * 16) = kreg[S][ii]; } \
                { const int sq = tid & 15, vc = tid >> 4; \
                  const int grp = ((sq >> 3) << 2) | (sq & 3), half = (sq >> 2) & 1; \
                  LAS unsigned char* vb = lds + VOFF + (buf) * VSZ + (vc * 8) * 160 + (grp << 4) + (half << 3); \
                  _Pragma("unroll") for (int d = 0; d < 4; ++d) { \
                      const unsigned a0 = vreg[S][0][d], a1 = vreg[S][1][d], a2 = vreg[S][2][d], a3 = vreg[S][3][d]; \
                      u32x2 ev, od; ev.x = (a0 & 0xffffu) | (a1 << 16); ev.y = (a2 & 0xffffu) | (a3 << 16); od.x = (a0 >> 16) | (a1 & 0xffff0000u); od.y = (a2 >> 16) | (a3 & 0xffff0000u); \
                      *(LAS u32x2*)(vb + (2 * d) * 160) = ev; *(LAS u32x2*)(vb + (2 * d + 1) * 160) = od; } } \
                { const float mx_ = wave_scan_max(areg[S]); amaxr[S] = __builtin_bit_cast(float, __builtin_amdgcn_readlane(__builtin_bit_cast(int, mx_), 63)); \
                  *(LAS float*)(lds + AOFF + (buf) * 256 + (tid & 63) * 4) = __expf(areg[S] - amaxr[S]); *(LAS float*)(lds + AROFF + (buf) * 256 + (tid & 63) * 4) = areg[S]; } } while (0)
            ML_LOAD(0, 0);
            ML_LOAD(min(1, qi), 1);
            ML_STORE(0, 0);
            __syncthreads();
            for (int kj = 0; kj <= qi; kj += 2) {
                ML_LOAD(min(kj + 2, qi), 0);
                ml_compute(lds, 0, kj == qi, tl, g, tb, vh, qf, Mt, amaxr[0], oacc, den);
                ML_STORE(1, 1);
                __syncthreads();
                if (kj + 1 > qi) break;
                ML_LOAD(min(kj + 3, qi), 1);
                ml_compute(lds, 1, kj + 1 == qi, tl, g, tb, vh, qf, Mt, amaxr[1], oacc, den);
                ML_STORE(0, 0);
                __syncthreads();
            }
#undef ML_LOAD
#undef ML_STORE
            den += __shfl_xor(den, 16); den += __shfl_xor(den, 32);
            const float mt = bcum[sidx] + Mt;
            const float inv = 1.0f / fmaxf(fabsf(den), __expf(-mt));
            float ssq = 0.f;
#pragma unroll
            for (int nb = 0; nb < 8; ++nb) { oacc[nb] *= inv; ssq += (oacc[nb][0] * oacc[nb][0] + oacc[nb][1] * oacc[nb][1]) + (oacc[nb][2] * oacc[nb][2] + oacc[nb][3] * oacc[nb][3]); }
            ssq += __shfl_xor(ssq, 16); ssq += __shfl_xor(ssq, 32);
            LAS float* SS = (LAS float*)(lds + SSOFF);
            if (g == 0) SS[vh * 64 + tb * 16 + tl] = ssq;
            __syncthreads();
            const float tot = SS[tb * 16 + tl] + SS[64 + tb * 16 + tl];
            const float rs = rsqrtf(tot * (1.0f / 256.0f) + EPS_);
            __syncthreads();
#pragma unroll
            for (int nb = 0; nb < 8; ++nb) {
                const int v = h * 256 + vh * 128 + nb * 16 + 4 * g;
                const u32x2 ow = *(const u32x2*)(proj + (size_t)trow * NP_ + 5120 + v);
                const f32x4 gm = *(const f32x4*)(p.in[7] + v);
                const float o0 = sigm(bflo(ow.x)) * oacc[nb][0] * rs * gm.x, o1 = sigm(bfhi(ow.x)) * oacc[nb][1] * rs * gm.y;
                const float o2 = sigm(bflo(ow.y)) * oacc[nb][2] * rs * gm.z, o3 = sigm(bfhi(ow.y)) * oacc[nb][3] * rs * gm.w;
                u32x2 ov; ov.x = pk_bf16(o0, o1); ov.y = pk_bf16(o2, o3);
                *(u32x2*)(y + (size_t)trow * D_ + 1024 + v) = ov;
            }
        }
    }
}

__device__ void phase_act(const Params& p, const int wv) {
    const bf16_t* up = (const bf16_t*)(p.ws + WS_UP);
    bf16_t* act = (bf16_t*)(p.ws + WS_ACT);
    const float* cw = p.in[11]; const float* cb = p.in[12];
    constexpr int NCH = DFF_ / 8;
    for (int it = blockIdx.x * 512 + TID_X; it < (T_ / 8) * NCH; it += gridDim.x * 512) {
        const int cc = it % NCH, run = it / NCH, c = cc * 8, t0 = run * 8;
        const bool first = (t0 & (SEQ_ - 1)) == 0;
        u32x4 gr[10], ur[10];
#pragma unroll
        for (int d = 0; d < 10; ++d) {
            const int t = (first && d < 2) ? t0 : t0 + d - 2;
            gr[d] = __builtin_nontemporal_load((const u32x4*)(up + (size_t)t * NUP_ + c)); ur[d] = __builtin_nontemporal_load((const u32x4*)(up + (size_t)t * NUP_ + DFF_ + c));
        }
        f32x4 wgv[4][2], wuv[4][2];
#pragma unroll
        for (int k = 0; k < 3; ++k)
#pragma unroll
            for (int hh = 0; hh < 2; ++hh) { wgv[k][hh] = *(const f32x4*)(cw + k * NUP_ + c + 4 * hh); wuv[k][hh] = *(const f32x4*)(cw + k * NUP_ + DFF_ + c + 4 * hh); }
#pragma unroll
        for (int hh = 0; hh < 2; ++hh) { wgv[3][hh] = *(const f32x4*)(cb + c + 4 * hh); wuv[3][hh] = *(const f32x4*)(cb + DFF_ + c + 4 * hh); }
        SCHED_FENCE();
        float g2[8], g1[8], u2[8], u1[8];
        unpack8(gr[0], g2); unpack8(ur[0], u2); unpack8(gr[1], g1); unpack8(ur[1], u1);
        if (first) {
#pragma unroll
            for (int j = 0; j < 8; ++j) { g2[j] = 0.f; g1[j] = 0.f; u2[j] = 0.f; u1[j] = 0.f; }
        }
#pragma unroll
        for (int dt = 0; dt < 8; ++dt) {
            float g0[8], u0[8], o[8];
            unpack8(gr[dt + 2], g0); unpack8(ur[dt + 2], u0);
#pragma unroll
            for (int j = 0; j < 8; ++j) {
                const float G = wgv[0][j >> 2][j & 3] * g2[j] + wgv[1][j >> 2][j & 3] * g1[j] + wgv[2][j >> 2][j & 3] * g0[j] + wgv[3][j >> 2][j & 3];
                const float U = wuv[0][j >> 2][j & 3] * u2[j] + wuv[1][j >> 2][j & 3] * u1[j] + wuv[2][j >> 2][j & 3] * u0[j] + wuv[3][j >> 2][j & 3];
                o[j] = G * sigm(G) * U;
                g2[j] = g1[j]; g1[j] = g0[j]; u2[j] = u1[j]; u1[j] = u0[j];
            }
            *(u32x4*)(act + (size_t)(t0 + dt) * DFF_ + c) = pack8(o);
        }
    }
}

__device__ void phase_final(const Params& p, const int wv) {
    const int wid = wv, lane = lane_id();
    const float* ss = (const float*)(p.ws + WS_SMALL + SM_SSA);
    const bf16_t* x3b = (const bf16_t*)(p.ws + WS_X3B);
    const float* gf = p.in[17];
    f32x4 g0[4], g1[4];
#pragma unroll
    for (int i = 0; i < 4; ++i) { const int k = (i * 64 + lane) * 8; g0[i] = *(const f32x4*)(gf + k); g1[i] = *(const f32x4*)(gf + k + 4); }
    for (int rb = (blockIdx.x * 8 + wid) * 4; rb < T_; rb += gridDim.x * 8 * 4) {
        float sp[4]; u32x4 w[4][4];
#pragma unroll
        for (int r = 0; r < 4; ++r) {
            sp[r] = (lane < 32) ? ss[(size_t)(rb + r) * 32 + lane] : 0.f;
#pragma unroll
            for (int i = 0; i < 4; ++i) w[r][i] = *(const u32x4*)(x3b + (size_t)(rb + r) * D_ + (i * 64 + lane) * 8);
        }
#pragma unroll
        for (int r = 0; r < 4; ++r) {
            const float rs = rsqrtf(wave_sum(sp[r]) * (1.0f / D_) + EPS_);
            float* xr = p.out + (size_t)(rb + r) * D_;
#pragma unroll
            for (int i = 0; i < 4; ++i) {
                const int k = (i * 64 + lane) * 8;
                float f[8]; unpack8(w[r][i], f);
                *(f32x4*)(xr + k) = (f32x4){f[0], f[1], f[2], f[3]} * rs * g0[i];
                *(f32x4*)(xr + k + 4) = (f32x4){f[4], f[5], f[6], f[7]} * rs * g1[i];
            }
        }
    }
}

__device__ __forceinline__ unsigned xcc_id() { return (unsigned)__builtin_amdgcn_s_getreg((3 << 11) | 20) & 7u; }
__device__ __forceinline__ void grid_barrier(unsigned* bar, const unsigned k, const int wv) {
    asm volatile("s_waitcnt vmcnt(0) lgkmcnt(0)" ::: "memory");
    __builtin_amdgcn_s_barrier();
    if (wv == 0) {
        const unsigned x = xcc_id();
        unsigned last = 0;
        if (lane_id() == 0) {
            if (k == 1u) {
                for (;;) { unsigned tot = 0;
                    for (int j = 0; j < 8; ++j) tot += __hip_atomic_load(bar + 64 * (9 + j), __ATOMIC_RELAXED, __HIP_MEMORY_SCOPE_AGENT);
                    if (tot >= gridDim.x) break; __builtin_amdgcn_s_sleep(1); } }
            const unsigned n = __hip_atomic_load(bar + 64 * (9 + x), __ATOMIC_RELAXED, __HIP_MEMORY_SCOPE_AGENT);
            const unsigned old = __hip_atomic_fetch_add(bar + 64 * (1 + x), 1u, __ATOMIC_RELAXED, __HIP_MEMORY_SCOPE_AGENT);
            last = (old + 1u == n * k) ? 1u : 0u;
        }
        last = (unsigned)__builtin_amdgcn_readfirstlane((int)last);
        if (last) {
            __builtin_amdgcn_fence(__ATOMIC_RELEASE, "agent");
            asm volatile("s_waitcnt vmcnt(0)" ::: "memory");
            if (lane_id() == 0) __hip_atomic_fetch_add(bar, 1u, __ATOMIC_RELAXED, __HIP_MEMORY_SCOPE_AGENT);
        }
        if (lane_id() == 0) {
            unsigned nx = 0;
            for (int j = 0; j < 8; ++j) nx += __hip_atomic_load(bar + 64 * (9 + j), __ATOMIC_RELAXED, __HIP_MEMORY_SCOPE_AGENT) ? 1u : 0u;
            while (__hip_atomic_load(bar, __ATOMIC_RELAXED, __HIP_MEMORY_SCOPE_AGENT) < nx * k) __builtin_amdgcn_s_sleep(1);
        }
        __builtin_amdgcn_fence(__ATOMIC_ACQUIRE, "agent");
        asm volatile("s_waitcnt vmcnt(0)" ::: "memory");
    }
    __builtin_amdgcn_s_barrier();
}

constexpr int N_PHASES = 8;
__global__ void __launch_bounds__(512, 2) fwd_kernel(Params p) {
    extern __shared__ __attribute__((aligned(16))) unsigned char lds_raw[];
    LAS unsigned char* lds = (LAS unsigned char*)lds_raw;
    unsigned char* ws = p.ws;
    pg8::StaticOrder S;
    const int wv = __builtin_amdgcn_readfirstlane((int)(threadIdx.x >> 6));
    unsigned* const gbar = (unsigned*)(ws + WS_SMALL + SM_BAR);
    unsigned nbar = 0;
#define PHASE_BEGIN(n) if (p.ph_lo <= (n) && (n) < p.ph_hi) {
#define PHASE_END(n) if ((n) + 1 < p.ph_hi) { ++nbar; grid_barrier(gbar, nbar, wv); } }
#define PHASE_END_CG(n) if ((n) + 1 < p.ph_hi) cg::this_grid().sync(); }
    if (p.ph_lo == 0 && p.ph_hi > 1) {
        if (blockIdx.x == 0 && threadIdx.x < 17) __hip_atomic_store(gbar + 64 * threadIdx.x, 0u, __ATOMIC_RELAXED, __HIP_MEMORY_SCOPE_AGENT);
        if (blockIdx.x == 1 && threadIdx.x < 32) __hip_atomic_store((unsigned*)(ws + WS_SMALL + SM_CNT) + 64 * threadIdx.x, 0u, __ATOMIC_RELAXED, __HIP_MEMORY_SCOPE_AGENT);
        cg::this_grid().sync();
        if (wv == 0 && lane_id() == 0) __hip_atomic_fetch_add(gbar + 64 * (9 + xcc_id()), 1u, __ATOMIC_RELAXED, __HIP_MEMORY_SCOPE_AGENT);
    }
    PHASE_BEGIN(0)
        phase_prep(p, lds, wv);
    PHASE_END(0)
    PHASE_BEGIN(1)
        if (wv == 0) for (int bh = blockIdx.x; bh < 16; bh += gridDim.x)
            scan_gates((const float*)(ws + WS_SMALL + SM_GATES), (float*)(ws + WS_SMALL + SM_ACUM), (float*)(ws + WS_SMALL + SM_MRUN), (float*)(ws + WS_SMALL + SM_BCUM), bh, lane_id());
        { pg8::Gemm g{(const bf16_t*)(ws + WS_XB), (const bf16_t*)(ws + WS_WIN), T_, NP_, D_}; S.init(T_, NP_, gridDim.x, blockIdx.x);
          EpiBf16Scale E{(bf16_t*)(ws + WS_PROJ), NP_, (const float*)(ws + WS_SMALL + SM_RSTD0)}; pg8::gemm_phase(lds, g, S, E, wv); }
    PHASE_END(1)
    PHASE_BEGIN(2)
        phase_convgroup(p, wv);
        phase_mlstm(p, lds, wv);
    PHASE_END(2)
    PHASE_BEGIN(3)
        { pg8::Gemm g{(const bf16_t*)(ws + WS_Y), (const bf16_t*)(ws + WS_WOUT), T_, D_, D_}; S.init(T_, D_, gridDim.x, blockIdx.x);
          EpiResidBf E{(const bf16_t*)(ws + WS_XB), (bf16_t*)p.out, (float*)(ws + WS_SMALL + SM_SSA)}; pg8::gemm_phase(lds, g, S, E, wv); }
    PHASE_END(3)
    PHASE_BEGIN(4)
        { pg8::Gemm g{(const bf16_t*)p.out, (const bf16_t*)(ws + WS_WUP), T_, NUP_, D_}; S.init(T_, NUP_, gridDim.x, blockIdx.x);
          EpiBf16Norm E{(bf16_t*)(ws + WS_UP), NUP_, (const float*)(ws + WS_SMALL + SM_SSA)}; pg8::gemm_phase(lds, g, S, E, wv); }
        { const int nunits = (T_ / 256) * (NUP_ / 256), nfull = nunits % (int)gridDim.x;
          const int worker = nfull ? (int)blockIdx.x - nfull : (int)blockIdx.x, nworkers = nfull ? (int)gridDim.x - nfull : (int)gridDim.x;
          if (worker >= 0) {
              convert_tiles(p, lds, NT_EARLY, NT_ALL, worker, nworkers, wv);
              __syncthreads();
              pg8::Gemm g2{(const bf16_t*)p.out + OUT_PB, (const bf16_t*)p.out + OUT_WPP, T_, D_, DPLE_}; S.init(T_, D_, nworkers, worker);
              EpiBf16Scale E2{(bf16_t*)(ws + WS_PP), D_, nullptr}; pg8::gemm_phase(lds, g2, S, E2, wv); } }
    PHASE_END(4)
    PHASE_BEGIN(5)
        phase_act(p, wv);
    PHASE_END(5)
    PHASE_BEGIN(6)
        { pg8::Gemm g{(const bf16_t*)(ws + WS_ACT), (const bf16_t*)(ws + WS_WDOWN), T_, D_, DFF_}; S.init(T_, D_, gridDim.x, blockIdx.x);
          EpiResidBf E{(const bf16_t*)p.out, (bf16_t*)(ws + WS_X2B2), (float*)(ws + WS_SMALL + SM_SSB)}; pg8::gemm_phase(lds, g, S, E, wv); }
    PHASE_END(6)
    PHASE_BEGIN(7)
        { pg8::Gemm g{(const bf16_t*)(ws + WS_X2B2), (const bf16_t*)(ws + WS_WPG), T_, D_, D_}; S.init(T_, D_, gridDim.x, blockIdx.x);
          EpiPleFinal E{(const bf16_t*)(ws + WS_X2B2), (const bf16_t*)(ws + WS_PP), (const float*)(ws + WS_SMALL + SM_SSB), (float*)(ws + WS_SMALL + SM_SSA),
                        (unsigned*)(ws + WS_SMALL + SM_CNT), p.in[17], p.out}; pg8::gemm_phase(lds, g, S, E, wv); }
    PHASE_END(7)
}

extern "C" void kernel_launch(void* const* d_in, const int* in_sizes, int n_in, void* d_out, int out_size, void* d_ws, size_t ws_size, hipStream_t stream) {
    static int grid = 0;
    if (grid == 0) {
        if (n_in != 18 || out_size != T_ * D_ || ws_size < WS_END) { fprintf(stderr, "kernel_launch: unexpected shapes: n_in %d out %d ws %zu (need %zu)\n", n_in, out_size, ws_size, (size_t)WS_END); grid = -1; return; }
        int dev = 0, cus = 0, per_cu = 0;
        hipGetDevice(&dev);
        hipDeviceGetAttribute(&cus, hipDeviceAttributeMultiprocessorCount, dev);
        if (hipFuncSetAttribute((const void*)fwd_kernel, hipFuncAttributeMaxDynamicSharedMemorySize, LDS_BYTES) != hipSuccess) { fprintf(stderr, "kernel_launch: hipFuncSetAttribute failed\n"); grid = -1; return; }
        if (hipOccupancyMaxActiveBlocksPerMultiprocessor(&per_cu, (const void*)fwd_kernel, 512, LDS_BYTES) != hipSuccess || per_cu < 1) { fprintf(stderr, "kernel_launch: occupancy query says %d\n", per_cu); per_cu = 1; (void)hipGetLastError(); }
        grid = cus * per_cu;
        if (grid > 256) grid = 256;
        fprintf(stderr, "kernel_launch: grid %d (cus %d x %d), ws %zu\n", grid, cus, per_cu, ws_size);
    }
    if (grid < 0) return;
    Params prm{};
    for (int i = 0; i < 18; ++i) prm.in[i] = (const float*)d_in[i];
    prm.out = (float*)d_out; prm.ws = (unsigned char*)d_ws;
#if N_LAUNCH_MODE == 1
    prm.ph_lo = 0; prm.ph_hi = N_PHASES;
    void* args[] = {&prm};
    hipError_t e = hipLaunchCooperativeKernel((const void*)fwd_kernel, dim3(grid), dim3(512), args, LDS_BYTES, stream);
    if (e != hipSuccess) fprintf(stderr, "kernel_launch: cooperative launch failed: %s (grid %d)\n", hipGetErrorString(e), grid);
#else
    for (int ph = 0; ph < N_PHASES; ++ph) {
        prm.ph_lo = ph; prm.ph_hi = ph + 1;
        hipLaunchKernelGGL(fwd_kernel, dim3(grid), dim3(512), LDS_BYTES, stream, prm);
    }
#endif
}
```

```cpp
#include <hip/hip_runtime.h>
#include <hip/hip_cooperative_groups.h>
#include <cstdio>
namespace cg = cooperative_groups;
#ifndef N_LAUNCH_MODE
#define N_LAUNCH_MODE 1
#endif
__device__ __forceinline__ int lane_id() { return (int)__builtin_amdgcn_mbcnt_hi(~0u, __builtin_amdgcn_mbcnt_lo(~0u, 0u)); }
#define TID_X (wv * 64 + lane_id())
namespace pg8 {
#define PG8_LAS __attribute__((address_space(3)))
typedef unsigned short bf16_t;
typedef short bf16x8 __attribute__((ext_vector_type(8)));
typedef float f32x4 __attribute__((ext_vector_type(4)));
typedef unsigned u32x4 __attribute__((ext_vector_type(4)));
constexpr int BM = 256, BK = 64, HALF = 128, HTB = HALF * BK * 2  , STAGE_BYTES = 8 * HTB, NXCD = 8, WGM = 8;

__host__ __device__ __forceinline__ int lds_byte(int r, int c) { const int st = (r >> 4) * 2 + (c >> 5), rr = r & 15, cc = c & 31, ob = rr * 64 + cc * 2; return st * 1024 + (ob ^ (((ob >> 9) & 1) << 5)); }
__host__ __device__ __forceinline__ void stage_rc(int b, int& R, int& C) { const int st = b / 1024, sb = b % 1024, swz = sb ^ (((sb >> 9) & 1) << 5); R = (st >> 1) * 16 + swz / 64; C = (st & 1) * 32 + (swz % 64) / 2; }
__host__ __device__ __forceinline__ int perm32(int rho) { const int n = rho >> 4, i = rho & 15; return 8 * (i >> 2) + 4 * n + (i & 3); }

struct Unit { int pm, pn; };
struct Gemm { const bf16_t* A; const bf16_t* Bt; int M, N, K; };

struct StaticOrder {
    int nM, nN, nwg, G, c;
    __host__ __device__ void init(int M, int N, int G_, int c_) { nM = M / BM; nN = N / BM; nwg = nM * nN; G = G_; c = c_; }
    __host__ __device__ bool next(int i, Unit& u) const {
        const long L = (long)i * G + c; if (L >= nwg) return false;
        int wgid = (int)L; { const int q = nwg / NXCD, r = nwg % NXCD, xcd = wgid % NXCD, off = wgid / NXCD; wgid = (xcd < r ? xcd * (q + 1) : r * (q + 1) + (xcd - r) * q) + off; }
        const int nig = WGM * nN, gid = wgid / nig, fm = gid * WGM, gsz = (nM - fm) < WGM ? (nM - fm) : WGM;
        u.pm = fm + ((wgid % nig) % gsz); u.pn = (wgid % nig) / gsz; return true;
    }
    __device__ __forceinline__ void a_ready(const Unit&) const {}
    __device__ __forceinline__ void done(const Unit&) const {}
};
template <class Epi, class Sched>
__device__ __forceinline__ void gemm_phase(PG8_LAS unsigned char* lds, const Gemm g, const Sched& S, const Epi& E, const int wv) {
    const int wid = wv, lane = lane_id(), tid = wv * 64 + lane, wr = wid >> 2, wc = wid & 3, fr = lane & 15, fq = lane >> 4;
    const int K = g.K, nt = K / BK;
    unsigned voffA[2], voffB[2];
#pragma unroll
    for (int i = 0; i < 2; ++i) { int R, C; stage_rc(tid * 16 + i * 8192, R, C); const int Rb = Epi::PERM ? ((R & ~31) + perm32(R & 31)) : R;
        voffA[i] = (unsigned)(R * K + C) * 2u; voffB[i] = (unsigned)(Rb * K + C) * 2u; }
    const size_t kstep = (size_t)(BK * 2);
    const size_t hstep = (size_t)HALF * K * 2;
    const size_t tstep = 2 * hstep;
    const unsigned ldsw = (unsigned)wid * 1024u;
    const int aoff = lds_byte(wr * 64 + fr, fq * 8), boff = lds_byte(wc * 32 + fr, fq * 8);
#define PG8_SA(b, h) (((b) * 2 + (h)) * HTB)
#define PG8_SB(b, h) ((4 + (b) * 2 + (h)) * HTB)
#define PG8_STAGE(bufoff, gbase, voff) do { _Pragma("unroll") for (int _i = 0; _i < 2; ++_i) \
        __builtin_amdgcn_global_load_lds((const unsigned*)((const char*)(gbase) + (voff)[_i]), (PG8_LAS unsigned*)(lds + (bufoff) + ldsw + _i * 8192), 16, 0, 0); } while (0)
#define PG8_LDA(dst, b, h) do { _Pragma("unroll") for (int m = 0; m < 4; ++m) _Pragma("unroll") for (int k = 0; k < 2; ++k) dst[m][k] = *(const PG8_LAS bf16x8*)(lds + PG8_SA(b, h) + aoff + m * 2048 + k * 1024); } while (0)
#define PG8_LDB(dst, b, h) do { _Pragma("unroll") for (int n = 0; n < 2; ++n) _Pragma("unroll") for (int k = 0; k < 2; ++k) dst[n][k] = *(const PG8_LAS bf16x8*)(lds + PG8_SB(b, h) + boff + n * 2048 + k * 1024); } while (0)
#define PG8_MMA(ai, bj, At, Bt) do { __builtin_amdgcn_s_setprio(1); _Pragma("unroll") for (int m = 0; m < 4; ++m) _Pragma("unroll") for (int n = 0; n < 2; ++n) _Pragma("unroll") for (int k = 0; k < 2; ++k) \
        acc[ai][bj][m][n] = __builtin_amdgcn_mfma_f32_16x16x32_bf16(Bt[n][k], At[m][k], acc[ai][bj][m][n], 0, 0, 0); __builtin_amdgcn_s_setprio(0); } while (0)
#define PG8_WAIT_V(n) asm volatile("s_waitcnt vmcnt(" #n ")" ::: "memory")
#define PG8_WAIT_L(n) asm volatile("s_waitcnt lgkmcnt(" #n ")" ::: "memory")
#define PG8_BAR __builtin_amdgcn_s_barrier()
#define PG8_SCHED __builtin_amdgcn_sched_barrier(0)
    Unit cur, nxt; int ui = 0;
    if (!S.next(0, cur)) return;
    f32x4 acc[2][2][4][2];
#pragma unroll
    for (int a = 0; a < 2; ++a)
#pragma unroll
        for (int b = 0; b < 2; ++b)
#pragma unroll
            for (int m = 0; m < 4; ++m)
#pragma unroll
                for (int n = 0; n < 2; ++n) acc[a][b][m][n] = (f32x4){0.f, 0.f, 0.f, 0.f};
    bf16x8 At[4][2], B0[2][2], B1[2][2];
    const char* cA = (const char*)g.A + (size_t)cur.pm * tstep; const char* cB = (const char*)g.Bt + (size_t)cur.pn * tstep;
    S.a_ready(cur);
    PG8_STAGE(PG8_SB(0, 0), cB, voffB); PG8_STAGE(PG8_SA(0, 0), cA, voffA); PG8_STAGE(PG8_SB(0, 1), cB + hstep, voffB); PG8_STAGE(PG8_SA(0, 1), cA + hstep, voffA);
    if (wr == 1) PG8_BAR;
    PG8_WAIT_V(4); PG8_BAR;
    PG8_STAGE(PG8_SB(1, 0), cB + kstep, voffB); PG8_STAGE(PG8_SA(1, 0), cA + kstep, voffA); PG8_STAGE(PG8_SB(1, 1), cB + hstep + kstep, voffB);
    PG8_WAIT_V(6); PG8_BAR;
    for (;;) {
        const bool has_next = S.next(ui + 1, nxt);
        const char* nA = has_next ? (const char*)g.A + (size_t)nxt.pm * tstep : cA; const char* nB = has_next ? (const char*)g.Bt + (size_t)nxt.pn * tstep : cB;
        for (int t = 0; t < nt; t += 2) {
            const bool last = (t == nt - 2);
            const char* a1 = cA + (size_t)(t + 1) * kstep;
            const char* a2 = last ? nA : cA + (size_t)(t + 2) * kstep; const char* b2 = last ? nB : cB + (size_t)(t + 2) * kstep;
            const char* a3 = a2 + kstep; const char* b3 = b2 + kstep;
            if (last && has_next) S.a_ready(nxt);
            PG8_LDB(B0, 0, 0); PG8_SCHED; PG8_LDA(At, 0, 0); PG8_STAGE(PG8_SA(1, 1), a1 + hstep, voffA);
            PG8_WAIT_L(8); PG8_BAR; PG8_WAIT_L(0); PG8_MMA(0, 0, At, B0); PG8_BAR; PG8_SCHED;
            PG8_LDB(B1, 0, 1); PG8_STAGE(PG8_SB(0, 0), b2, voffB);
            PG8_BAR; PG8_WAIT_L(0); PG8_MMA(0, 1, At, B1); PG8_BAR;
            PG8_LDA(At, 0, 1); PG8_STAGE(PG8_SA(0, 0), a2, voffA);
            PG8_BAR; PG8_WAIT_L(0); PG8_MMA(1, 0, At, B0); PG8_BAR; PG8_SCHED;
            PG8_STAGE(PG8_SB(0, 1), b2 + hstep, voffB);
            PG8_WAIT_V(6); PG8_BAR; PG8_MMA(1, 1, At, B1); PG8_BAR;
            PG8_LDB(B0, 1, 0); PG8_SCHED; PG8_LDA(At, 1, 0); PG8_STAGE(PG8_SA(0, 1), a2 + hstep, voffA);
            PG8_WAIT_L(8); PG8_BAR; PG8_WAIT_L(0); PG8_MMA(0, 0, At, B0); PG8_BAR; PG8_SCHED;
            PG8_LDB(B1, 1, 1); PG8_STAGE(PG8_SB(1, 0), b3, voffB);
            PG8_BAR; PG8_WAIT_L(0); PG8_MMA(0, 1, At, B1); PG8_BAR;
            PG8_LDA(At, 1, 1); PG8_STAGE(PG8_SA(1, 0), a3, voffA);
            PG8_BAR; PG8_WAIT_L(0); PG8_MMA(1, 0, At, B0); PG8_BAR; PG8_SCHED;
            PG8_STAGE(PG8_SB(1, 1), b3 + hstep, voffB);
            PG8_WAIT_V(6); PG8_BAR; PG8_MMA(1, 1, At, B1); PG8_BAR;
        }
        if constexpr (!Epi::AFTER_DRAIN) { E(acc, cur, wr, wc, fr, fq); S.done(cur); }
        if (!has_next) break;
#pragma unroll
        for (int a = 0; a < 2; ++a)
#pragma unroll
            for (int b = 0; b < 2; ++b)
#pragma unroll
                for (int m = 0; m < 4; ++m)
#pragma unroll
                    for (int n = 0; n < 2; ++n) acc[a][b][m][n] = (f32x4){0.f, 0.f, 0.f, 0.f};
        cur = nxt; cA = nA; cB = nB; ++ui;
    }
    PG8_WAIT_V(0);
    if (wr == 0) PG8_BAR;
    PG8_BAR;
    if constexpr (Epi::AFTER_DRAIN) { E.fused(acc, cur, wr, wc, fr, fq, lds, wid, lane); S.done(cur); }
#undef PG8_SA
#undef PG8_SB
#undef PG8_STAGE
#undef PG8_LDA
#undef PG8_LDB
#undef PG8_MMA
#undef PG8_WAIT_V
#undef PG8_WAIT_L
#undef PG8_BAR
#undef PG8_SCHED
}
}
using pg8::bf16_t; using pg8::bf16x8; using pg8::f32x4; using pg8::u32x4; using pg8::Unit;
#define LAS __attribute__((address_space(3)))
typedef unsigned u32x2 __attribute__((ext_vector_type(2)));

constexpr int T_ = 8192, D_ = 2048, NP_ = 6144, NPF_ = 6152, DFF_ = 5632, NUP_ = 11264, DPLE_ = 256, SEQ_ = 2048;
constexpr float EPS_ = 1e-6f;
constexpr size_t MiB = (size_t)1 << 20;
constexpr size_t WS_SMALL = 0, WS_WPG = 3 * MiB, WS_WDOWN = 11 * MiB, WS_PP = 33 * MiB,
                 WS_PROJ = 65 * MiB, WS_WOUT = 161 * MiB, WS_WPP = 169 * MiB, WS_PB = 170 * MiB,
                 WS_UP = 65 * MiB, WS_X2B = 65 * MiB, WS_WUP = 241 * MiB, WS_X1B = 285 * MiB, WS_WIN = 285 * MiB,
                 WS_XB = 317 * MiB, WS_Y = 285 * MiB, WS_ACT = 241 * MiB, WS_X3B = 65 * MiB, WS_X2B2 = 100 * MiB, WS_END = 349 * MiB;
constexpr size_t OUT_PB = (size_t)T_ * D_, OUT_WPP = (size_t)T_ * D_ + (size_t)T_ * DPLE_;
constexpr size_t SM_RSTD0 = 0, SM_GATES = 64 * 1024, SM_ACUM = 320 * 1024, SM_MRUN = 448 * 1024, SM_BCUM = 576 * 1024, SM_CNT = 704 * 1024, SM_BAR = 960 * 1024, SM_SSA = 1 * MiB, SM_SSB = 2 * MiB;
constexpr int LDS_BYTES = 131072 + 1024;

struct Params { const float* in[18]; float* out; unsigned char* ws; int ph_lo, ph_hi; };

__device__ __forceinline__ unsigned pk_bf16(float lo, float hi) { unsigned r; asm("v_cvt_pk_bf16_f32 %0, %1, %2" : "=v"(r) : "v"(lo), "v"(hi)); return r; }
__device__ __forceinline__ float bflo(unsigned w) { return __uint_as_float(w << 16); }
__device__ __forceinline__ float bfhi(unsigned w) { return __uint_as_float(w & 0xffff0000u); }
__device__ __forceinline__ float sigm(float x) { return __builtin_amdgcn_rcpf(1.0f + __expf(-x)); }
__device__ __forceinline__ float wave_sum(float v) {
#pragma unroll
    for (int o = 32; o; o >>= 1) v += __shfl_xor(v, o);
    return v;
}
__device__ __forceinline__ void unpack8(const u32x4 w, float (&f)[8]) {
    f[0] = bflo(w.x); f[1] = bfhi(w.x); f[2] = bflo(w.y); f[3] = bfhi(w.y); f[4] = bflo(w.z); f[5] = bfhi(w.z); f[6] = bflo(w.w); f[7] = bfhi(w.w);
}
__device__ __forceinline__ u32x4 pack8(const float (&f)[8]) { u32x4 w; w.x = pk_bf16(f[0], f[1]); w.y = pk_bf16(f[2], f[3]); w.z = pk_bf16(f[4], f[5]); w.w = pk_bf16(f[6], f[7]); return w; }

struct TileDesc { const float* src; bf16_t* dst; const float* gk; int N, ldt, k0, n0; float cs; };
__device__ __forceinline__ TileDesc tile_desc(const Params& p, int l) {
    constexpr int NT_IN = 32 * 96, NT_PP = 4 * 32, NT_OUT = 32 * 32, NT_UP = 32 * 176, NT_DOWN = 88 * 32;
    unsigned char* ws = p.ws; TileDesc d; d.cs = 1.0f; d.gk = nullptr; int ntn;
    if (l < NT_IN) { ntn = 96; d.src = p.in[3]; d.N = NPF_; d.dst = (bf16_t*)(ws + WS_WIN); d.ldt = D_; d.gk = p.in[2]; const int nt = l % 96; if (nt >= 48 && nt < 56) d.cs = 0.08838834764831845f; }
    else if ((l -= NT_IN) < NT_PP) { ntn = 32; d.src = p.in[16]; d.N = D_; d.dst = (bf16_t*)p.out + OUT_WPP; d.ldt = DPLE_; }
    else if ((l -= NT_PP) < NT_OUT) { ntn = 32; d.src = p.in[8]; d.N = D_; d.dst = (bf16_t*)(ws + WS_WOUT); d.ldt = D_; }
    else if ((l -= NT_OUT) < NT_UP) { ntn = 176; d.src = p.in[10]; d.N = NUP_; d.dst = (bf16_t*)(ws + WS_WUP); d.ldt = D_; d.gk = p.in[9]; }
    else if ((l -= NT_UP) < NT_DOWN) { ntn = 32; d.src = p.in[13]; d.N = D_; d.dst = (bf16_t*)(ws + WS_WDOWN); d.ldt = DFF_; }
    else { l -= NT_DOWN; ntn = 32; d.src = p.in[15]; d.N = D_; d.dst = (bf16_t*)(ws + WS_WPG); d.ldt = D_; d.gk = p.in[14]; }
    d.n0 = (l % ntn) * 64; d.k0 = (l / ntn) * 64; return d;
}

constexpr int NT_EARLY = 32 * 96 + 4 * 32 + 32 * 32 + 32 * 176;
constexpr int NT_ALL = NT_EARLY + 88 * 32 + 32 * 32;
__device__ void convert_tiles(const Params& p, LAS unsigned char* lds, const int first, const int last, const int worker, const int nworkers, const int wv) {
    const int tid = TID_X;
    const int n4 = tid & 15, kp = tid >> 4, r = tid >> 3, c = tid & 7;
    for (int i4 = first + worker * 4; i4 < last; i4 += nworkers * 4) {
        f32x4 a[4], b[4]; float g0[4], g1[4];
#pragma unroll
        for (int u = 0; u < 4; ++u) {
            const TileDesc d = tile_desc(p, i4 + u);
            const float* src = d.src + (size_t)(d.k0 + 2 * kp) * d.N + d.n0 + 4 * n4;
            a[u] = __builtin_nontemporal_load((const f32x4*)src); b[u] = __builtin_nontemporal_load((const f32x4*)(src + d.N));
            g0[u] = d.cs; g1[u] = d.cs;
            if (d.gk) { g0[u] *= d.gk[d.k0 + 2 * kp]; g1[u] *= d.gk[d.k0 + 2 * kp + 1]; }
        }
        __syncthreads();
#pragma unroll
        for (int u = 0; u < 4; ++u) {
            LAS unsigned* l32 = (LAS unsigned*)(lds + u * 8448);
#pragma unroll
            for (int j = 0; j < 4; ++j) l32[(4 * n4 + j) * 33 + kp] = pk_bf16(a[u][j] * g0[u], b[u][j] * g1[u]);
        }
        __syncthreads();
#pragma unroll
        for (int u = 0; u < 4; ++u) {
            const TileDesc d = tile_desc(p, i4 + u);
            LAS unsigned* l32 = (LAS unsigned*)(lds + u * 8448);
            u32x4 o; o.x = l32[r * 33 + 4 * c]; o.y = l32[r * 33 + 4 * c + 1]; o.z = l32[r * 33 + 4 * c + 2]; o.w = l32[r * 33 + 4 * c + 3];
            *(u32x4*)(d.dst + (size_t)(d.n0 + r) * d.ldt + d.k0 + 8 * c) = o;
        }
    }
}

__device__ void phase_prep(const Params& p, LAS unsigned char* lds, const int wv) {
    const int wid = wv, lane = lane_id(), tid = wv * 64 + lane;
    unsigned char* ws = p.ws;
    convert_tiles(p, lds, 0, NT_EARLY, blockIdx.x, gridDim.x, wv);
    __syncthreads();
    LAS float* wg = (LAS float*)(lds + 32768);
    for (int i = tid; i < 2048 * 2; i += 512) {
        const int k = i >> 1, hf = i & 1;
        f32x4 v = *(const f32x4*)(p.in[3] + (size_t)k * NPF_ + NP_ + 4 * hf);
        const float g = p.in[2][k];
#pragma unroll
        for (int j = 0; j < 4; ++j) wg[(4 * hf + j) * 2048 + k] = v[j] * g;
    }
    __syncthreads();
    bf16_t* xb = (bf16_t*)(ws + WS_XB);
    float* rstd0 = (float*)(ws + WS_SMALL + SM_RSTD0);
    float* gates = (float*)(ws + WS_SMALL + SM_GATES);
    for (int row = blockIdx.x * 8 + wid; row < T_; row += gridDim.x * 8) {
        const float* xr = p.in[0] + (size_t)row * D_;
        float ss = 0.f, dots[8];
#pragma unroll
        for (int j = 0; j < 8; ++j) dots[j] = 0.f;
#pragma unroll
        for (int i = 0; i < 8; ++i) {
            const int k = (i * 64 + lane) * 4;
            const f32x4 v = __builtin_nontemporal_load((const f32x4*)(xr + k));
            ss += v.x * v.x + v.y * v.y + v.z * v.z + v.w * v.w;
            u32x2 o; o.x = pk_bf16(v.x, v.y); o.y = pk_bf16(v.z, v.w);
            *(u32x2*)(xb + (size_t)row * D_ + k) = o;
#pragma unroll
            for (int j = 0; j < 8; ++j) { const f32x4 w = *(const LAS f32x4*)(wg + j * 2048 + k); dots[j] += v.x * w.x + v.y * w.y + v.z * w.z + v.w * w.w; }
        }
        ss = wave_sum(ss);
#pragma unroll
        for (int j = 0; j < 8; ++j) dots[j] = wave_sum(dots[j]);
        const float rs = rsqrtf(ss * (1.0f / D_) + EPS_);
        if (lane == 0) rstd0[row] = rs;
        if (lane < 8) {
            float d = dots[0];
#pragma unroll
            for (int j = 1; j < 8; ++j) d = (lane == j) ? dots[j] : d;
            const float bias = (lane < 4) ? p.in[4][lane & 3] : p.in[5][lane & 3];
            gates[(size_t)row * 8 + lane] = rs * d + bias;
        }
    }
    {
        bf16_t* pb = (bf16_t*)p.out + OUT_PB;
        const size_t n4 = (size_t)T_ * DPLE_ / 4;
        for (size_t i = (size_t)blockIdx.x * 512 + tid; i < n4; i += (size_t)gridDim.x * 512) {
            const f32x4 v = __builtin_nontemporal_load((const f32x4*)(p.in[1] + i * 4));
            u32x2 o; o.x = pk_bf16(v.x, v.y); o.y = pk_bf16(v.z, v.w);
            *(u32x2*)(pb + i * 4) = o;
        }
    }
}

#define DPPF(old, x, ctrl, rmask) __builtin_bit_cast(float, __builtin_amdgcn_update_dpp(__builtin_bit_cast(int, (float)(old)), __builtin_bit_cast(int, (float)(x)), ctrl, rmask, 0xf, false))
__device__ __forceinline__ float wave_scan_add(float v) {
    v += DPPF(0.f, v, 0x111, 0xf); v += DPPF(0.f, v, 0x112, 0xf); v += DPPF(0.f, v, 0x114, 0xf); v += DPPF(0.f, v, 0x118, 0xf);
    v += DPPF(0.f, v, 0x142, 0xa); v += DPPF(0.f, v, 0x143, 0xc);
    return v;
}
__device__ __forceinline__ float wave_scan_max(float v) {
    const float ninf = -__builtin_inff();
    v = fmaxf(v, DPPF(ninf, v, 0x111, 0xf)); v = fmaxf(v, DPPF(ninf, v, 0x112, 0xf)); v = fmaxf(v, DPPF(ninf, v, 0x114, 0xf)); v = fmaxf(v, DPPF(ninf, v, 0x118, 0xf));
    v = fmaxf(v, DPPF(ninf, v, 0x142, 0xa)); v = fmaxf(v, DPPF(ninf, v, 0x143, 0xc));
    return v;
}
__device__ void scan_gates(const float* gates, float* acum, float* mrun, float* bcum, int bh, int lane) {
    const int batch = bh >> 2, h = bh & 3;
    float fgv[32], igv[32];
#pragma unroll
    for (int r = 0; r < 32; ++r) { const size_t t = (size_t)batch * SEQ_ + r * 64 + lane; fgv[r] = gates[t * 8 + 4 + h]; igv[r] = gates[t * 8 + h]; }
    float carryB = 0.f, carryM = 0.f;
#pragma unroll
    for (int r = 0; r < 32; ++r) {
        const int s = r * 64 + lane;
        const float fg = fgv[r], ig = igv[r];
        const float lf = -(fmaxf(-fg, 0.f) + log1pf(expf(-fabsf(fg))));
        const float B = carryB + wave_scan_add(lf);
        const float a = ig - B;
        const float M = fmaxf(carryM, wave_scan_max(a));
        acum[bh * SEQ_ + s] = a; mrun[bh * SEQ_ + s] = M; bcum[bh * SEQ_ + s] = B;
        carryB = __builtin_bit_cast(float, __builtin_amdgcn_readlane(__builtin_bit_cast(int, B), 63));
        carryM = __builtin_bit_cast(float, __builtin_amdgcn_readlane(__builtin_bit_cast(int, M), 63));
    }
}

#define SCHED_FENCE() __builtin_amdgcn_sched_barrier(0)
__device__ __forceinline__ void store_bf16_rows(const f32x4 (&acc)[2][2][4][2], bf16_t* O, int ldc, int row0, int col0, const float (&rs)[2][4]) {
#pragma unroll
    for (int ai = 0; ai < 2; ++ai)
#pragma unroll
        for (int m = 0; m < 4; ++m) {
            bf16_t* rowp = O + (size_t)(row0 + ai * 128 + m * 16) * ldc + col0;
            const float r = rs[ai][m];
#pragma unroll
            for (int bj = 0; bj < 2; ++bj) {
                const f32x4 v0 = acc[ai][bj][m][0] * r, v1 = acc[ai][bj][m][1] * r;
                u32x4 w; w.x = pk_bf16(v0[0], v0[1]); w.y = pk_bf16(v0[2], v0[3]); w.z = pk_bf16(v1[0], v1[1]); w.w = pk_bf16(v1[2], v1[3]);
                *(u32x4*)(rowp + bj * 128) = w;
            }
        }
}
struct EpiBf16Scale {
    static constexpr bool PERM = true, AFTER_DRAIN = false;
    bf16_t* O; int ldc; const float* rowscale;
    __device__ __forceinline__ void operator()(const f32x4 (&acc)[2][2][4][2], const Unit& u, int wr, int wc, int fr, int fq) const {
        const int row0 = u.pm * 256 + wr * 64 + fr, col0 = u.pn * 256 + wc * 32 + 8 * fq;
        float rs[2][4];
#pragma unroll
        for (int ai = 0; ai < 2; ++ai)
#pragma unroll
            for (int m = 0; m < 4; ++m) rs[ai][m] = rowscale ? rowscale[row0 + ai * 128 + m * 16] : 1.0f;
        SCHED_FENCE();
        store_bf16_rows(acc, O, ldc, row0, col0, rs);
    }
};
__device__ __forceinline__ void rstd_rows(const float* ss, int row0, int fq, float (&rs)[2][4]) {
    f32x4 a[2][4], b[2][4];
#pragma unroll
    for (int ai = 0; ai < 2; ++ai)
#pragma unroll
        for (int m = 0; m < 4; ++m) { const float* q = ss + (size_t)(row0 + ai * 128 + m * 16) * 32 + 8 * fq; a[ai][m] = *(const f32x4*)q; b[ai][m] = *(const f32x4*)(q + 4); }
    SCHED_FENCE();
#pragma unroll
    for (int ai = 0; ai < 2; ++ai)
#pragma unroll
        for (int m = 0; m < 4; ++m) {
            const f32x4 x = a[ai][m], y = b[ai][m];
            float t = ((x.x + x.y) + (x.z + x.w)) + ((y.x + y.y) + (y.z + y.w));
            t += __shfl_xor(t, 16); t += __shfl_xor(t, 32);
            rs[ai][m] = rsqrtf(t * (1.0f / D_) + EPS_);
        }
}
struct EpiBf16Norm {
    static constexpr bool PERM = true, AFTER_DRAIN = false;
    bf16_t* O; int ldc; const float* ss;
    __device__ __forceinline__ void operator()(const f32x4 (&acc)[2][2][4][2], const Unit& u, int wr, int wc, int fr, int fq) const {
        const int row0 = u.pm * 256 + wr * 64 + fr, col0 = u.pn * 256 + wc * 32 + 8 * fq;
        float rs[2][4];
        rstd_rows(ss, row0, fq, rs);
        SCHED_FENCE();
        store_bf16_rows(acc, O, ldc, row0, col0, rs);
    }
};
struct EpiResidBf {
    static constexpr bool PERM = true, AFTER_DRAIN = false;
    const bf16_t* base; bf16_t* ob; float* ssout;
    __device__ __forceinline__ void operator()(const f32x4 (&acc)[2][2][4][2], const Unit& u, int wr, int wc, int fr, int fq) const {
        const int row0 = u.pm * 256 + wr * 64 + fr, col0 = u.pn * 256 + wc * 32 + 8 * fq;
        u32x4 r[4][2];
#define ER_LOAD(q) do { const size_t off_ = (size_t)(row0 + ((q) >> 2) * 128 + ((q) & 3) * 16) * D_ + col0; r[(q) & 3][0] = *(const u32x4*)(base + off_); r[(q) & 3][1] = *(const u32x4*)(base + off_ + 128); } while (0)
        ER_LOAD(0); ER_LOAD(1); ER_LOAD(2);
#pragma unroll
        for (int q = 0; q < 8; ++q) {
            const int ai = q >> 2, m = q & 3;
            if (q + 3 < 8) ER_LOAD(q + 3);
            SCHED_FENCE();
            const int row = row0 + ai * 128 + m * 16;
            const size_t off = (size_t)row * D_ + col0;
            float s = 0.f;
#pragma unroll
            for (int bj = 0; bj < 2; ++bj) {
                float f[8]; unpack8(r[q & 3][bj], f);
                const f32x4 v0 = acc[ai][bj][m][0] + (f32x4){f[0], f[1], f[2], f[3]}, v1 = acc[ai][bj][m][1] + (f32x4){f[4], f[5], f[6], f[7]};
                u32x4 w; w.x = pk_bf16(v0[0], v0[1]); w.y = pk_bf16(v0[2], v0[3]); w.z = pk_bf16(v1[0], v1[1]); w.w = pk_bf16(v1[2], v1[3]);
                *(u32x4*)(ob + off + bj * 128) = w;
                s += (v0[0] * v0[0] + v0[1] * v0[1]) + (v0[2] * v0[2] + v0[3] * v0[3]) + (v1[0] * v1[0] + v1[1] * v1[1]) + (v1[2] * v1[2] + v1[3] * v1[3]);
            }
            s += __shfl_xor(s, 16); s += __shfl_xor(s, 32);
            if (fq == 0) ssout[(size_t)row * 32 + u.pn * 4 + wc] = s;
            SCHED_FENCE();
        }
#undef ER_LOAD
    }
};
struct EpiPleGateBf {
    static constexpr bool PERM = true, AFTER_DRAIN = false;
    const bf16_t* base; bf16_t* ob; const bf16_t* pp; const float* ssin; float* ssout;
    __device__ __forceinline__ void operator()(const f32x4 (&acc)[2][2][4][2], const Unit& u, int wr, int wc, int fr, int fq) const {
        const int row0 = u.pm * 256 + wr * 64 + fr, col0 = u.pn * 256 + wc * 32 + 8 * fq;
        float rs[2][4];
        rstd_rows(ssin, row0, fq, rs);
        u32x4 r[2][2], pw[2][2];
#define EP_LOAD(slot, q) do { const size_t off_ = (size_t)(row0 + ((q) >> 2) * 128 + ((q) & 3) * 16) * D_ + col0; \
            r[slot][0] = *(const u32x4*)(base + off_); r[slot][1] = *(const u32x4*)(base + off_ + 128); \
            pw[slot][0] = *(const u32x4*)(pp + off_); pw[slot][1] = *(const u32x4*)(pp + off_ + 128); } while (0)
        EP_LOAD(0, 0);
#pragma unroll
        for (int q = 0; q < 8; ++q) {
            const int ai = q >> 2, m = q & 3, sl = q & 1;
            if (q + 1 < 8) EP_LOAD((q + 1) & 1, q + 1);
            SCHED_FENCE();
            const int row = row0 + ai * 128 + m * 16;
            const size_t off = (size_t)row * D_ + col0;
            const float rsv = rs[ai][m];
            float s = 0.f;
#pragma unroll
            for (int bj = 0; bj < 2; ++bj) {
                float pf[8], xf[8]; unpack8(pw[sl][bj], pf); unpack8(r[sl][bj], xf);
                f32x4 v0, v1;
#pragma unroll
                for (int j = 0; j < 4; ++j) { v0[j] = xf[j] + sigm(acc[ai][bj][m][0][j] * rsv) * pf[j]; v1[j] = xf[4 + j] + sigm(acc[ai][bj][m][1][j] * rsv) * pf[4 + j]; }
                u32x4 w; w.x = pk_bf16(v0[0], v0[1]); w.y = pk_bf16(v0[2], v0[3]); w.z = pk_bf16(v1[0], v1[1]); w.w = pk_bf16(v1[2], v1[3]);
                *(u32x4*)(ob + off + bj * 128) = w;
                s += (v0[0] * v0[0] + v0[1] * v0[1]) + (v0[2] * v0[2] + v0[3] * v0[3]) + (v1[0] * v1[0] + v1[1] * v1[1]) + (v1[2] * v1[2] + v1[3] * v1[3]);
            }
            s += __shfl_xor(s, 16); s += __shfl_xor(s, 32);
            if (fq == 0) ssout[(size_t)row * 32 + u.pn * 4 + wc] = s;
            SCHED_FENCE();
        }
#undef EP_LOAD
    }
};

struct EpiPleFinal {
    static constexpr bool PERM = true, AFTER_DRAIN = true, APERM = false;
    const bf16_t* base; const bf16_t* pp; const float* ssin; float* ssx; unsigned* cnt; const float* gf; float* out;
    __device__ __forceinline__ void fused(const f32x4 (&acc)[2][2][4][2], const Unit& u, int wr, int wc, int fr, int fq, LAS unsigned char*, int, int) const {
        const int row0 = u.pm * 256 + wr * 64 + fr, col0 = u.pn * 256 + wc * 32 + 8 * fq;
        float rs[2][4];
        rstd_rows(ssin, row0, fq, rs);
        u32x4 xk[8][2];
        u32x4 r[2][2], pw[2][2];
#define EP_LOAD(slot, q) do { const size_t off_ = (size_t)(row0 + ((q) >> 2) * 128 + ((q) & 3) * 16) * D_ + col0; \
            r[slot][0] = *(const u32x4*)(base + off_); r[slot][1] = *(const u32x4*)(base + off_ + 128); \
            pw[slot][0] = *(const u32x4*)(pp + off_); pw[slot][1] = *(const u32x4*)(pp + off_ + 128); } while (0)
        EP_LOAD(0, 0);
#pragma unroll
        for (int q = 0; q < 8; ++q) {
            const int ai = q >> 2, m = q & 3, sl = q & 1;
            if (q + 1 < 8) EP_LOAD((q + 1) & 1, q + 1);
            SCHED_FENCE();
            const int row = row0 + ai * 128 + m * 16;
            const float rsv = rs[ai][m];
            float s = 0.f;
#pragma unroll
            for (int bj = 0; bj < 2; ++bj) {
                float pf[8], xf[8]; unpack8(pw[sl][bj], pf); unpack8(r[sl][bj], xf);
                f32x4 v0, v1;
#pragma unroll
                for (int j = 0; j < 4; ++j) { v0[j] = xf[j] + sigm(acc[ai][bj][m][0][j] * rsv) * pf[j]; v1[j] = xf[4 + j] + sigm(acc[ai][bj][m][1][j] * rsv) * pf[4 + j]; }
                u32x4 w; w.x = pk_bf16(v0[0], v0[1]); w.y = pk_bf16(v0[2], v0[3]); w.z = pk_bf16(v1[0], v1[1]); w.w = pk_bf16(v1[2], v1[3]);
                xk[q][bj] = w;
                s += (v0[0] * v0[0] + v0[1] * v0[1]) + (v0[2] * v0[2] + v0[3] * v0[3]) + (v1[0] * v1[0] + v1[1] * v1[1]) + (v1[2] * v1[2] + v1[3] * v1[3]);
            }
            s += __shfl_xor(s, 16); s += __shfl_xor(s, 32);
            if (fq == 0) __hip_atomic_store(ssx + (size_t)row * 32 + u.pn * 4 + wc, s, __ATOMIC_RELAXED, __HIP_MEMORY_SCOPE_AGENT);
            SCHED_FENCE();
        }
#undef EP_LOAD
        asm volatile("s_waitcnt vmcnt(0)" ::: "memory");
        unsigned* const c = cnt + 64 * u.pm;
        if (fr == 0 && fq == 0) __hip_atomic_fetch_add(c, 1u, __ATOMIC_RELAXED, __HIP_MEMORY_SCOPE_AGENT);
        if (wr == 0 && wc == 0) {
            for (unsigned spins = 0; spins < (1u << 22); ++spins) {
                if ((unsigned)__builtin_amdgcn_readfirstlane((int)__hip_atomic_load(c, __ATOMIC_RELAXED, __HIP_MEMORY_SCOPE_AGENT)) >= 64u) break;
                __builtin_amdgcn_s_sleep(1);
            }
            __builtin_amdgcn_fence(__ATOMIC_ACQUIRE, "agent");
            asm volatile("s_waitcnt vmcnt(0)" ::: "memory");
        }
        __builtin_amdgcn_s_barrier();
        asm volatile("" ::: "memory");
        float rs3[2][4];
        rstd_rows(ssx, row0, fq, rs3);
        f32x4 gfv[2][2];
#pragma unroll
        for (int bj = 0; bj < 2; ++bj) { gfv[bj][0] = *(const f32x4*)(gf + col0 + bj * 128); gfv[bj][1] = *(const f32x4*)(gf + col0 + bj * 128 + 4); }
#pragma unroll
        for (int q = 0; q < 8; ++q) {
            const int ai = q >> 2, m = q & 3;
            const size_t off = (size_t)(row0 + ai * 128 + m * 16) * D_ + col0;
            const float rv = rs3[ai][m];
#pragma unroll
            for (int bj = 0; bj < 2; ++bj) {
                float f[8]; unpack8(xk[q][bj], f);
                *(f32x4*)(out + off + bj * 128) = (f32x4){f[0], f[1], f[2], f[3]} * rv * gfv[bj][0];
                *(f32x4*)(out + off + bj * 128 + 4) = (f32x4){f[4], f[5], f[6], f[7]} * rv * gfv[bj][1];
            }
        }
    }
};

__device__ void phase_convgroup(const Params& p, const int wv) {
    const bf16_t* proj = (const bf16_t*)(p.ws + WS_PROJ);
    bf16_t* y = (bf16_t*)(p.ws + WS_Y);
    const float* cw = p.in[6];
    for (int it = blockIdx.x * 512 + TID_X; it < (T_ / 8) * 128; it += gridDim.x * 512) {
        const int cc = it & 127, run = it >> 7, c = cc * 8, t0 = run * 8;
        float w0[8], w1[8], w2[8], p2[8], p1[8];
#pragma unroll
        for (int j = 0; j < 8; ++j) { w0[j] = cw[c + j]; w1[j] = cw[1024 + c + j]; w2[j] = cw[2048 + c + j]; p2[j] = 0.f; p1[j] = 0.f; }
        if ((t0 & (SEQ_ - 1)) != 0) {
            float a[8], b[8];
            unpack8(*(const u32x4*)(proj + (size_t)(t0 - 2) * NP_ + 1024 + c), a); unpack8(*(const u32x4*)(proj + (size_t)(t0 - 2) * NP_ + 2048 + c), b);
#pragma unroll
            for (int j = 0; j < 8; ++j) p2[j] = a[j] * b[j];
            unpack8(*(const u32x4*)(proj + (size_t)(t0 - 1) * NP_ + 1024 + c), a); unpack8(*(const u32x4*)(proj + (size_t)(t0 - 1) * NP_ + 2048 + c), b);
#pragma unroll
            for (int j = 0; j < 8; ++j) p1[j] = a[j] * b[j];
        }
#pragma unroll
        for (int dt = 0; dt < 8; ++dt) {
            const size_t ro = (size_t)(t0 + dt) * NP_;
            float gb[8], gc[8], uu[8], o[8];
            unpack8(*(const u32x4*)(proj + ro + c), gb); unpack8(*(const u32x4*)(proj + ro + 1024 + c), gc); unpack8(*(const u32x4*)(proj + ro + 2048 + c), uu);
#pragma unroll
            for (int j = 0; j < 8; ++j) { const float cur = gc[j] * uu[j]; o[j] = gb[j] * (w0[j] * p2[j] + w1[j] * p1[j] + w2[j] * cur); p2[j] = p1[j]; p1[j] = cur; }
            *(u32x4*)(y + (size_t)(t0 + dt) * D_ + c) = pack8(o);
        }
    }
}

constexpr int ML_KOFF = 0, ML_KSZ = 64 * 288, ML_VOFF = 2 * ML_KSZ, ML_VSZ = 256 * 160, ML_AOFF = ML_VOFF + 2 * ML_VSZ, ML_AROFF = ML_AOFF + 512, ML_SSOFF = ML_AROFF + 512;
__device__ __forceinline__ void ml_compute(LAS unsigned char* lds, const int buf, const bool diag, const int tl, const int g, const int tb, const int vh,
                                           const bf16x8 (&qf)[4], const float Mt, const float amax, f32x4 (&oacc)[8], float& den) {
    constexpr int KOFF = ML_KOFF, KSZ = ML_KSZ, VOFF = ML_VOFF, VSZ = ML_VSZ, AOFF = ML_AOFF, AROFF = ML_AROFF;
    LAS unsigned char* const kfb = lds + tl * 288 + g * 16;
    LAS unsigned char* const afb = lds + g * 16;
    LAS unsigned char* const vfb0 = lds + (vh * 128 + tl) * 160 + g * 16;
                u32x4 pf[2];
                f32x4 sa[4];
#pragma unroll
                for (int sh = 0; sh < 2; ++sh) {
                    bf16x8 kf[2][4];
#pragma unroll
                    for (int s2 = 0; s2 < 2; ++s2)
#pragma unroll
                        for (int kk = 0; kk < 4; ++kk) kf[s2][kk] = *(const LAS bf16x8*)(kfb + (KOFF + buf * KSZ + 16 * (2 * sh + s2) * 288 + 64 * kk));
                    SCHED_FENCE();
                    sa[2 * sh] = (f32x4){0.f, 0.f, 0.f, 0.f}; sa[2 * sh + 1] = (f32x4){0.f, 0.f, 0.f, 0.f};
#pragma unroll
                    for (int kk = 0; kk < 4; ++kk)
#pragma unroll
                        for (int s2 = 0; s2 < 2; ++s2) sa[2 * sh + s2] = __builtin_amdgcn_mfma_f32_16x16x32_bf16(kf[s2][kk], qf[kk], sa[2 * sh + s2], 0, 0, 0);
                    SCHED_FENCE();
                }
                bf16x8 vf[4];
#pragma unroll
                for (int i = 0; i < 4; ++i) { const int nb = i >> 1, k2 = i & 1;
                    vf[i] = *(const LAS bf16x8*)(vfb0 + (VOFF + buf * VSZ + nb * 16 * 160 + k2 * 64)); }
                f32x4 a4[4];
                if (!diag) {
#pragma unroll
                    for (int sb = 0; sb < 4; ++sb) a4[sb] = *(const LAS f32x4*)(afb + (AOFF + buf * 256 + 64 * sb));
                    SCHED_FENCE();
                    const float et = __expf(amax - Mt);
#pragma unroll
                    for (int sb = 0; sb < 4; ++sb) {
                        const f32x4 pv = sa[sb] * (a4[sb] * et);
                        den += (pv[0] + pv[1]) + (pv[2] + pv[3]);
                        const unsigned lo = pk_bf16(pv[0], pv[1]), hi = pk_bf16(pv[2], pv[3]);
                        if (sb & 1) { pf[sb >> 1].z = lo; pf[sb >> 1].w = hi; } else { pf[sb >> 1].x = lo; pf[sb >> 1].y = hi; }
                    }
                } else {
#pragma unroll
                    for (int sb = 0; sb < 4; ++sb) a4[sb] = *(const LAS f32x4*)(afb + (AROFF + buf * 256 + 64 * sb));
                    SCHED_FENCE();
#pragma unroll
                    for (int sb = 0; sb < 4; ++sb) {
                        float pv[4];
#pragma unroll
                        for (int j = 0; j < 4; ++j) {
                            float w = __expf(a4[sb][j] - Mt);
                            if ((16 * sb + 4 * g + j) > (tb * 16 + tl)) w = 0.f;
                            pv[j] = sa[sb][j] * w; den += pv[j];
                        }
                        const unsigned lo = pk_bf16(pv[0], pv[1]), hi = pk_bf16(pv[2], pv[3]);
                        if (sb & 1) { pf[sb >> 1].z = lo; pf[sb >> 1].w = hi; } else { pf[sb >> 1].x = lo; pf[sb >> 1].y = hi; }
                    }
                }
                SCHED_FENCE();
                const bf16x8 pb0 = __builtin_bit_cast(bf16x8, pf[0]), pb1 = __builtin_bit_cast(bf16x8, pf[1]);
#pragma unroll
                for (int qd = 0; qd < 4; ++qd) {
#pragma unroll
                    for (int i = 0; i < 4; ++i) oacc[2 * qd + (i >> 1)] = __builtin_amdgcn_mfma_f32_16x16x32_bf16(vf[i], (i & 1) ? pb1 : pb0, oacc[2 * qd + (i >> 1)], 0, 0, 0);
                    if (qd < 3) {
#pragma unroll
                        for (int i = 0; i < 4; ++i) { const int nb = 2 * (qd + 1) + (i >> 1), k2 = i & 1;
                            vf[i] = *(const LAS bf16x8*)(vfb0 + (VOFF + buf * VSZ + nb * 16 * 160 + k2 * 64)); }
                        SCHED_FENCE();
                    }
                }
}

__device__ void phase_mlstm(const Params& p, LAS unsigned char* lds, const int wv) {
    const int wid = wv, lane = lane_id(), tid = wv * 64 + lane, tl = lane & 15, g = lane >> 4, tb = wid & 3, vh = wid >> 2;
    const bf16_t* proj = (const bf16_t*)(p.ws + WS_PROJ);
    bf16_t* y = (bf16_t*)(p.ws + WS_Y);
    const float* acum = (const float*)(p.ws + WS_SMALL + SM_ACUM);
    const float* mrun = (const float*)(p.ws + WS_SMALL + SM_MRUN);
    const float* bcum = (const float*)(p.ws + WS_SMALL + SM_BCUM);
    constexpr int KOFF = ML_KOFF, KSZ = ML_KSZ, VOFF = ML_VOFF, VSZ = ML_VSZ, AOFF = ML_AOFF, AROFF = ML_AROFF, SSOFF = ML_SSOFF;
    for (int pr = blockIdx.x; pr < 256; pr += gridDim.x) {
        const int xx = pr & 7, jj = pr >> 3;
        const int bh = 2 * xx + (jj >> 4), ip = jj & 15, batch = bh >> 2, h = bh & 3;
        for (int which = 0; which < 2; ++which) {
            const int qi = which ? ip : 31 - ip;
            const int trow = batch * SEQ_ + qi * 64 + tb * 16 + tl;
            const int sidx = bh * SEQ_ + qi * 64 + tb * 16 + tl;
            bf16x8 qf[4];
#pragma unroll
            for (int kk = 0; kk < 4; ++kk) qf[kk] = *(const bf16x8*)(proj + (size_t)trow * NP_ + 3072 + h * 128 + 32 * kk + 8 * g);
            const float Mt = mrun[sidx];
            f32x4 oacc[8];
#pragma unroll
            for (int nb = 0; nb < 8; ++nb) oacc[nb] = (f32x4){0.f, 0.f, 0.f, 0.f};
            float den = 0.f;
            u32x4 kreg[2][2], vreg[2][4]; float areg[2] = {0.f, 0.f}, amaxr[2] = {0.f, 0.f};
            const bf16_t* kbase = proj + (size_t)batch * SEQ_ * NP_ + 3584 + h * 128;
            const bf16_t* vbase = proj + (size_t)batch * SEQ_ * NP_ + 4096 + h * 256;
            const unsigned koff = (unsigned)((tid >> 4) * NP_ + (tid & 15) * 8), voff = (unsigned)(4 * (tid & 15) * NP_ + (tid >> 4) * 8);
#define ML_LOAD(kj, S) do { \
                { const bf16_t* kt_ = kbase + (size_t)(kj) * 64 * NP_; const bf16_t* vt_ = vbase + (size_t)(kj) * 64 * NP_; \
                  kreg[S][0] = *(const u32x4*)(kt_ + koff); kreg[S][1] = *(const u32x4*)(kt_ + 32 * NP_ + koff); \
                  _Pragma("unroll") for (int ii = 0; ii < 4; ++ii) vreg[S][ii] = *(const u32x4*)(vt_ + ii * NP_ + voff); } \
                areg[S] = acum[bh * SEQ_ + (kj) * 64 + (tid & 63)]; } while (0)
#define ML_STORE(buf, S) do { \
                _Pragma("unroll") for (int ii = 0; ii < 2; ++ii) { const int ch = tid + 512 * ii; *(LAS u32x4*)(lds + KOFF + (buf) * KSZ + (ch >> 4) * 288 + (ch & 15) * 16) = kreg[S][ii]; } \
                { const int sq = tid & 15, vc = tid >> 4; \
                  const int grp = ((sq >> 3) << 2) | (sq & 3), half = (sq >> 2) & 1; \
                  LAS unsigned char* vb = lds + VOFF + (buf) * VSZ + (vc * 8) * 160 + (grp << 4) + (half << 3); \
                  _Pragma("unroll") for (int d = 0; d < 4; ++d) { \
                      const unsigned a0 = vreg[S][0][d], a1 = vreg[S][1][d], a2 = vreg[S][2][d], a3 = vreg[S][3][d]; \
                      u32x2 ev, od; ev.x = (a0 & 0xffffu) | (a1 << 16); ev.y = (a2 & 0xffffu) | (a3 << 16); od.x = (a0 >> 16) | (a1 & 0xffff0000u); od.y = (a2 >> 16) | (a3 & 0xffff0000u); \
                      *(LAS u32x2*)(vb + (2 * d) * 160) = ev; *(LAS u32x2*)(vb + (2 * d + 1) * 160) = od; } } \
                { const float mx_ = wave_scan_max(areg[S]); amaxr[S] = __builtin_bit_cast(float, __builtin_amdgcn_readlane(__builtin_bit_cast(int, mx_), 63)); \
                  *(LAS float*)(lds + AOFF + (buf) * 256 + (tid & 63) * 4) = __expf(areg[S] - amaxr[S]); *(LAS float*)(lds + AROFF + (buf) * 256 + (tid & 63) * 4) = areg[S]; } } while (0)
            ML_LOAD(0, 0);
            ML_LOAD(min(1, qi), 1);
            ML_STORE(0, 0);
            __syncthreads();
            for (int kj = 0; kj <= qi; kj += 2) {
                ML_LOAD(min(kj + 2, qi), 0);
                ml_compute(lds, 0, kj == qi, tl, g, tb, vh, qf, Mt, amaxr[0], oacc, den);
                ML_STORE(1, 1);
                __syncthreads();
                if (kj + 1 > qi) break;
                ML_LOAD(min(kj + 3, qi), 1);
                ml_compute(lds, 1, kj + 1 == qi, tl, g, tb, vh, qf, Mt, amaxr[1], oacc, den);
                ML_STORE(0, 0);
                __syncthreads();
            }
#undef ML_LOAD
#undef ML_STORE
            u32x2 owv[8];
#pragma unroll
            for (int nb = 0; nb < 8; ++nb) owv[nb] = *(const u32x2*)(proj + (size_t)trow * NP_ + 5120 + h * 256 + vh * 128 + nb * 16 + 4 * g);
            const float bct = bcum[sidx];
            den += __shfl_xor(den, 16); den += __shfl_xor(den, 32);
            const float mt = bct + Mt;
            const float inv = 1.0f / fmaxf(fabsf(den), __expf(-mt));
            float ssq = 0.f;
#pragma unroll
            for (int nb = 0; nb < 8; ++nb) { oacc[nb] *= inv; ssq += (oacc[nb][0] * oacc[nb][0] + oacc[nb][1] * oacc[nb][1]) + (oacc[nb][2] * oacc[nb][2] + oacc[nb][3] * oacc[nb][3]); }
            ssq += __shfl_xor(ssq, 16); ssq += __shfl_xor(ssq, 32);
            LAS float* SS = (LAS float*)(lds + SSOFF);
            if (g == 0) SS[vh * 64 + tb * 16 + tl] = ssq;
            __syncthreads();
            const float tot = SS[tb * 16 + tl] + SS[64 + tb * 16 + tl];
            const float rs = rsqrtf(tot * (1.0f / 256.0f) + EPS_);
            __syncthreads();
#pragma unroll
            for (int nb = 0; nb < 8; ++nb) {
                const int v = h * 256 + vh * 128 + nb * 16 + 4 * g;
                const u32x2 ow = owv[nb];
                const f32x4 gm = *(const f32x4*)(p.in[7] + v);
                const float o0 = sigm(bflo(ow.x)) * oacc[nb][0] * rs * gm.x, o1 = sigm(bfhi(ow.x)) * oacc[nb][1] * rs * gm.y;
                const float o2 = sigm(bflo(ow.y)) * oacc[nb][2] * rs * gm.z, o3 = sigm(bfhi(ow.y)) * oacc[nb][3] * rs * gm.w;
                u32x2 ov; ov.x = pk_bf16(o0, o1); ov.y = pk_bf16(o2, o3);
                *(u32x2*)(y + (size_t)trow * D_ + 1024 + v) = ov;
            }
        }
    }
}

__device__ void phase_act(const Params& p, const int wv) {
    const bf16_t* up = (const bf16_t*)(p.ws + WS_UP);
    bf16_t* act = (bf16_t*)(p.ws + WS_ACT);
    const float* cw = p.in[11]; const float* cb = p.in[12];
    constexpr int NCH = DFF_ / 8;
    for (int it = blockIdx.x * 512 + TID_X; it < (T_ / 8) * NCH; it += gridDim.x * 512) {
        const int cc = it % NCH, run = it / NCH, c = cc * 8, t0 = run * 8;
        const bool first = (t0 & (SEQ_ - 1)) == 0;
        u32x4 gr[10], ur[10];
#pragma unroll
        for (int d = 0; d < 10; ++d) {
            const int t = (first && d < 2) ? t0 : t0 + d - 2;
            gr[d] = __builtin_nontemporal_load((const u32x4*)(up + (size_t)t * NUP_ + c)); ur[d] = __builtin_nontemporal_load((const u32x4*)(up + (size_t)t * NUP_ + DFF_ + c));
        }
        f32x4 wgv[4][2], wuv[4][2];
#pragma unroll
        for (int k = 0; k < 3; ++k)
#pragma unroll
            for (int hh = 0; hh < 2; ++hh) { wgv[k][hh] = *(const f32x4*)(cw + k * NUP_ + c + 4 * hh); wuv[k][hh] = *(const f32x4*)(cw + k * NUP_ + DFF_ + c + 4 * hh); }
#pragma unroll
        for (int hh = 0; hh < 2; ++hh) { wgv[3][hh] = *(const f32x4*)(cb + c + 4 * hh); wuv[3][hh] = *(const f32x4*)(cb + DFF_ + c + 4 * hh); }
        SCHED_FENCE();
        float g2[8], g1[8], u2[8], u1[8];
        unpack8(gr[0], g2); unpack8(ur[0], u2); unpack8(gr[1], g1); unpack8(ur[1], u1);
        if (first) {
#pragma unroll
            for (int j = 0; j < 8; ++j) { g2[j] = 0.f; g1[j] = 0.f; u2[j] = 0.f; u1[j] = 0.f; }
        }
#pragma unroll
        for (int dt = 0; dt < 8; ++dt) {
            float g0[8], u0[8], o[8];
            unpack8(gr[dt + 2], g0); unpack8(ur[dt + 2], u0);
#pragma unroll
            for (int j = 0; j < 8; ++j) {
                const float G = wgv[0][j >> 2][j & 3] * g2[j] + wgv[1][j >> 2][j & 3] * g1[j] + wgv[2][j >> 2][j & 3] * g0[j] + wgv[3][j >> 2][j & 3];
                const float U = wuv[0][j >> 2][j & 3] * u2[j] + wuv[1][j >> 2][j & 3] * u1[j] + wuv[2][j >> 2][j & 3] * u0[j] + wuv[3][j >> 2][j & 3];
                o[j] = G * sigm(G) * U;
                g2[j] = g1[j]; g1[j] = g0[j]; u2[j] = u1[j]; u1[j] = u0[j];
            }
            *(u32x4*)(act + (size_t)(t0 + dt) * DFF_ + c) = pack8(o);
        }
    }
}

__device__ void phase_final(const Params& p, const int wv) {
    const int wid = wv, lane = lane_id();
    const float* ss = (const float*)(p.ws + WS_SMALL + SM_SSA);
    const bf16_t* x3b = (const bf16_t*)(p.ws + WS_X3B);
    const float* gf = p.in[17];
    f32x4 g0[4], g1[4];
#pragma unroll
    for (int i = 0; i < 4; ++i) { const int k = (i * 64 + lane) * 8; g0[i] = *(const f32x4*)(gf + k); g1[i] = *(const f32x4*)(gf + k + 4); }
    for (int rb = (blockIdx.x * 8 + wid) * 4; rb < T_; rb += gridDim.x * 8 * 4) {
        float sp[4]; u32x4 w[4][4];
#pragma unroll
        for (int r = 0; r < 4; ++r) {
            sp[r] = (lane < 32) ? ss[(size_t)(rb + r) * 32 + lane] : 0.f;
#pragma unroll
            for (int i = 0; i < 4; ++i) w[r][i] = *(const u32x4*)(x3b + (size_t)(rb + r) * D_ + (i * 64 + lane) * 8);
        }
#pragma unroll
        for (int r = 0; r < 4; ++r) {
            const float rs = rsqrtf(wave_sum(sp[r]) * (1.0f / D_) + EPS_);
            float* xr = p.out + (size_t)(rb + r) * D_;
#pragma unroll
            for (int i = 0; i < 4; ++i) {
                const int k = (i * 64 + lane) * 8;
                float f[8]; unpack8(w[r][i], f);
                *(f32x4*)(xr + k) = (f32x4){f[0], f[1], f[2], f[3]} * rs * g0[i];
                *(f32x4*)(xr + k + 4) = (f32x4){f[4], f[5], f[6], f[7]} * rs * g1[i];
            }
        }
    }
}

__device__ __forceinline__ unsigned xcc_id() { return (unsigned)__builtin_amdgcn_s_getreg((3 << 11) | 20) & 7u; }
__device__ __forceinline__ void grid_barrier(unsigned* bar, const unsigned k, const int wv) {
    asm volatile("s_waitcnt vmcnt(0) lgkmcnt(0)" ::: "memory");
    __builtin_amdgcn_s_barrier();
    if (wv == 0) {
        const unsigned x = xcc_id();
        unsigned last = 0;
        if (lane_id() == 0) {
            if (k == 1u) {
                for (;;) { unsigned tot = 0;
                    for (int j = 0; j < 8; ++j) tot += __hip_atomic_load(bar + 64 * (9 + j), __ATOMIC_RELAXED, __HIP_MEMORY_SCOPE_AGENT);
                    if (tot >= gridDim.x) break; __builtin_amdgcn_s_sleep(1); } }
            const unsigned n = __hip_atomic_load(bar + 64 * (9 + x), __ATOMIC_RELAXED, __HIP_MEMORY_SCOPE_AGENT);
            const unsigned old = __hip_atomic_fetch_add(bar + 64 * (1 + x), 1u, __ATOMIC_RELAXED, __HIP_MEMORY_SCOPE_AGENT);
            last = (old + 1u == n * k) ? 1u : 0u;
        }
        last = (unsigned)__builtin_amdgcn_readfirstlane((int)last);
        if (last) {
            __builtin_amdgcn_fence(__ATOMIC_RELEASE, "agent");
            asm volatile("s_waitcnt vmcnt(0)" ::: "memory");
            if (lane_id() == 0) __hip_atomic_fetch_add(bar, 1u, __ATOMIC_RELAXED, __HIP_MEMORY_SCOPE_AGENT);
        }
        if (lane_id() == 0) {
            unsigned nx = 0;
            for (int j = 0; j < 8; ++j) nx += __hip_atomic_load(bar + 64 * (9 + j), __ATOMIC_RELAXED, __HIP_MEMORY_SCOPE_AGENT) ? 1u : 0u;
            while (__hip_atomic_load(bar, __ATOMIC_RELAXED, __HIP_MEMORY_SCOPE_AGENT) < nx * k) __builtin_amdgcn_s_sleep(1);
        }
        __builtin_amdgcn_fence(__ATOMIC_ACQUIRE, "agent");
        asm volatile("s_waitcnt vmcnt(0)" ::: "memory");
    }
    __builtin_amdgcn_s_barrier();
}

constexpr int N_PHASES = 8;
__global__ void __launch_bounds__(512, 2) fwd_kernel(Params p) {
    extern __shared__ __attribute__((aligned(16))) unsigned char lds_raw[];
    LAS unsigned char* lds = (LAS unsigned char*)lds_raw;
    unsigned char* ws = p.ws;
    pg8::StaticOrder S;
    const int wv = __builtin_amdgcn_readfirstlane((int)(threadIdx.x >> 6));
    unsigned* const gbar = (unsigned*)(ws + WS_SMALL + SM_BAR);
    unsigned nbar = 0;
#define PHASE_BEGIN(n) if (p.ph_lo <= (n) && (n) < p.ph_hi) {
#define PHASE_END(n) if ((n) + 1 < p.ph_hi) { ++nbar; grid_barrier(gbar, nbar, wv); } }
#define PHASE_END_CG(n) if ((n) + 1 < p.ph_hi) cg::this_grid().sync(); }
    if (p.ph_lo == 0 && p.ph_hi > 1) {
        if (blockIdx.x == 0 && threadIdx.x < 17) __hip_atomic_store(gbar + 64 * threadIdx.x, 0u, __ATOMIC_RELAXED, __HIP_MEMORY_SCOPE_AGENT);
        if (blockIdx.x == 1 && threadIdx.x < 32) __hip_atomic_store((unsigned*)(ws + WS_SMALL + SM_CNT) + 64 * threadIdx.x, 0u, __ATOMIC_RELAXED, __HIP_MEMORY_SCOPE_AGENT);
        cg::this_grid().sync();
        if (wv == 0 && lane_id() == 0) __hip_atomic_fetch_add(gbar + 64 * (9 + xcc_id()), 1u, __ATOMIC_RELAXED, __HIP_MEMORY_SCOPE_AGENT);
    }
    PHASE_BEGIN(0)
        phase_prep(p, lds, wv);
    PHASE_END(0)
    PHASE_BEGIN(1)
        if (wv == 0) for (int bh = blockIdx.x; bh < 16; bh += gridDim.x)
            scan_gates((const float*)(ws + WS_SMALL + SM_GATES), (float*)(ws + WS_SMALL + SM_ACUM), (float*)(ws + WS_SMALL + SM_MRUN), (float*)(ws + WS_SMALL + SM_BCUM), bh, lane_id());
        { pg8::Gemm g{(const bf16_t*)(ws + WS_XB), (const bf16_t*)(ws + WS_WIN), T_, NP_, D_}; S.init(T_, NP_, gridDim.x, blockIdx.x);
          EpiBf16Scale E{(bf16_t*)(ws + WS_PROJ), NP_, (const float*)(ws + WS_SMALL + SM_RSTD0)}; pg8::gemm_phase(lds, g, S, E, wv); }
    PHASE_END(1)
    PHASE_BEGIN(2)
        phase_convgroup(p, wv);
        phase_mlstm(p, lds, wv);
    PHASE_END(2)
    PHASE_BEGIN(3)
        { pg8::Gemm g{(const bf16_t*)(ws + WS_Y), (const bf16_t*)(ws + WS_WOUT), T_, D_, D_}; S.init(T_, D_, gridDim.x, blockIdx.x);
          EpiResidBf E{(const bf16_t*)(ws + WS_XB), (bf16_t*)p.out, (float*)(ws + WS_SMALL + SM_SSA)}; pg8::gemm_phase(lds, g, S, E, wv); }
    PHASE_END(3)
    PHASE_BEGIN(4)
        { pg8::Gemm g{(const bf16_t*)p.out, (const bf16_t*)(ws + WS_WUP), T_, NUP_, D_}; S.init(T_, NUP_, gridDim.x, blockIdx.x);
          EpiBf16Norm E{(bf16_t*)(ws + WS_UP), NUP_, (const float*)(ws + WS_SMALL + SM_SSA)}; pg8::gemm_phase(lds, g, S, E, wv); }
        { const int nunits = (T_ / 256) * (NUP_ / 256), nfull = nunits % (int)gridDim.x;
          const int worker = nfull ? (int)blockIdx.x - nfull : (int)blockIdx.x, nworkers = nfull ? (int)gridDim.x - nfull : (int)gridDim.x;
          if (worker >= 0) {
              convert_tiles(p, lds, NT_EARLY, NT_ALL, worker, nworkers, wv);
              __syncthreads();
              pg8::Gemm g2{(const bf16_t*)p.out + OUT_PB, (const bf16_t*)p.out + OUT_WPP, T_, D_, DPLE_}; S.init(T_, D_, nworkers, worker);
              EpiBf16Scale E2{(bf16_t*)(ws + WS_PP), D_, nullptr}; pg8::gemm_phase(lds, g2, S, E2, wv); } }
    PHASE_END(4)
    PHASE_BEGIN(5)
        phase_act(p, wv);
    PHASE_END(5)
    PHASE_BEGIN(6)
        { pg8::Gemm g{(const bf16_t*)(ws + WS_ACT), (const bf16_t*)(ws + WS_WDOWN), T_, D_, DFF_}; S.init(T_, D_, gridDim.x, blockIdx.x);
          EpiResidBf E{(const bf16_t*)p.out, (bf16_t*)(ws + WS_X2B2), (float*)(ws + WS_SMALL + SM_SSB)}; pg8::gemm_phase(lds, g, S, E, wv); }
    PHASE_END(6)
    PHASE_BEGIN(7)
        { pg8::Gemm g{(const bf16_t*)(ws + WS_X2B2), (const bf16_t*)(ws + WS_WPG), T_, D_, D_}; S.init(T_, D_, gridDim.x, blockIdx.x);
          EpiPleFinal E{(const bf16_t*)(ws + WS_X2B2), (const bf16_t*)(ws + WS_PP), (const float*)(ws + WS_SMALL + SM_SSB), (float*)(ws + WS_SMALL + SM_SSA),
                        (unsigned*)(ws + WS_SMALL + SM_CNT), p.in[17], p.out}; pg8::gemm_phase(lds, g, S, E, wv); }
    PHASE_END(7)
}

extern "C" void kernel_launch(void* const* d_in, const int* in_sizes, int n_in, void* d_out, int out_size, void* d_ws, size_t ws_size, hipStream_t stream) {
    static int grid = 0;
    if (grid == 0) {
        if (n_in != 18 || out_size != T_ * D_ || ws_size < WS_END) { fprintf(stderr, "kernel_launch: unexpected shapes: n_in %d out %d ws %zu (need %zu)\n", n_in, out_size, ws_size, (size_t)WS_END); grid = -1; return; }
        int dev = 0, cus = 0, per_cu = 0;
        hipGetDevice(&dev);
        hipDeviceGetAttribute(&cus, hipDeviceAttributeMultiprocessorCount, dev);
        if (hipFuncSetAttribute((const void*)fwd_kernel, hipFuncAttributeMaxDynamicSharedMemorySize, LDS_BYTES) != hipSuccess) { fprintf(stderr, "kernel_launch: hipFuncSetAttribute failed\n"); grid = -1; return; }
        if (hipOccupancyMaxActiveBlocksPerMultiprocessor(&per_cu, (const void*)fwd_kernel, 512, LDS_BYTES) != hipSuccess || per_cu < 1) { fprintf(stderr, "kernel_launch: occupancy query says %d\n", per_cu); per_cu = 1; (void)hipGetLastError(); }
        grid = cus * per_cu;
        if (grid > 256) grid = 256;
        fprintf(stderr, "kernel_launch: grid %d (cus %d x %d), ws %zu\n", grid, cus, per_cu, ws_size);
    }
    if (grid < 0) return;
    Params prm{};
    for (int i = 0; i < 18; ++i) prm.in[i] = (const float*)d_in[i];
    prm.out = (float*)d_out; prm.ws = (unsigned char*)d_ws;
#if N_LAUNCH_MODE == 1
    prm.ph_lo = 0; prm.ph_hi = N_PHASES;
    void* args[] = {&prm};
    hipError_t e = hipLaunchCooperativeKernel((const void*)fwd_kernel, dim3(grid), dim3(512), args, LDS_BYTES, stream);
    if (e != hipSuccess) fprintf(stderr, "kernel_launch: cooperative launch failed: %s (grid %d)\n", hipGetErrorString(e), grid);
#else
    for (int ph = 0; ph < N_PHASES; ++ph) {
        prm.ph_lo = ph; prm.ph_hi = ph + 1;
        hipLaunchKernelGGL(fwd_kernel, dim3(grid), dim3(512), LDS_BYTES, stream, prm);
    }
#endif
}
```

```cpp
#include <hip/hip_runtime.h>
#include <hip/hip_cooperative_groups.h>
#include <cstdio>
namespace cg = cooperative_groups;
#ifndef N_LAUNCH_MODE
#define N_LAUNCH_MODE 1
#endif
__device__ __forceinline__ int lane_id() { return (int)__builtin_amdgcn_mbcnt_hi(~0u, __builtin_amdgcn_mbcnt_lo(~0u, 0u)); }
#define TID_X (wv * 64 + lane_id())
namespace pg8 {
#define PG8_LAS __attribute__((address_space(3)))
typedef unsigned short bf16_t;
typedef short bf16x8 __attribute__((ext_vector_type(8)));
typedef float f32x4 __attribute__((ext_vector_type(4)));
typedef unsigned u32x4 __attribute__((ext_vector_type(4)));
constexpr int BM = 256, BK = 64, HALF = 128, HTB = HALF * BK * 2  , STAGE_BYTES = 8 * HTB, NXCD = 8, WGM = 4;

__host__ __device__ __forceinline__ int lds_byte(int r, int c) { const int st = (r >> 4) * 2 + (c >> 5), rr = r & 15, cc = c & 31, ob = rr * 64 + cc * 2; return st * 1024 + (ob ^ (((ob >> 9) & 1) << 5)); }
__host__ __device__ __forceinline__ void stage_rc(int b, int& R, int& C) { const int st = b / 1024, sb = b % 1024, swz = sb ^ (((sb >> 9) & 1) << 5); R = (st >> 1) * 16 + swz / 64; C = (st & 1) * 32 + (swz % 64) / 2; }
__host__ __device__ __forceinline__ int perm32(int rho) { const int n = rho >> 4, i = rho & 15; return 8 * (i >> 2) + 4 * n + (i & 3); }

struct Unit { int pm, pn; };
struct Gemm { const bf16_t* A; const bf16_t* Bt; int M, N, K; };

struct StaticOrder {
    int nM, nN, nwg, G, c;
    __host__ __device__ void init(int M, int N, int G_, int c_) { nM = M / BM; nN = N / BM; nwg = nM * nN; G = G_; c = c_; }
    __host__ __device__ bool next(int i, Unit& u) const {
        const long L = (long)i * G + c; if (L >= nwg) return false;
        int wgid = (int)L; { const int q = nwg / NXCD, r = nwg % NXCD, xcd = wgid % NXCD, off = wgid / NXCD; wgid = (xcd < r ? xcd * (q + 1) : r * (q + 1) + (xcd - r) * q) + off; }
        const int nig = WGM * nN, gid = wgid / nig, fm = gid * WGM, gsz = (nM - fm) < WGM ? (nM - fm) : WGM;
        u.pm = fm + ((wgid % nig) % gsz); u.pn = (wgid % nig) / gsz; return true;
    }
    __device__ __forceinline__ void a_ready(const Unit&) const {}
    __device__ __forceinline__ void done(const Unit&) const {}
};
template <class Epi, class Sched>
__device__ __forceinline__ void gemm_phase(PG8_LAS unsigned char* lds, const Gemm g, const Sched& S, const Epi& E, const int wv) {
    const int wid = wv, lane = lane_id(), tid = wv * 64 + lane, wr = wid >> 2, wc = wid & 3, fr = lane & 15, fq = lane >> 4;
    const int K = g.K, nt = K / BK;
    unsigned voffA[2], voffB[2];
#pragma unroll
    for (int i = 0; i < 2; ++i) { int R, C; stage_rc(tid * 16 + i * 8192, R, C); const int Rb = Epi::PERM ? ((R & ~31) + perm32(R & 31)) : R;
        voffA[i] = (unsigned)(R * K + C) * 2u; voffB[i] = (unsigned)(Rb * K + C) * 2u; }
    const size_t kstep = (size_t)(BK * 2);
    const size_t hstep = (size_t)HALF * K * 2;
    const size_t tstep = 2 * hstep;
    const unsigned ldsw = (unsigned)wid * 1024u;
    const int aoff = lds_byte(wr * 64 + fr, fq * 8), boff = lds_byte(wc * 32 + fr, fq * 8);
#define PG8_SA(b, h) (((b) * 2 + (h)) * HTB)
#define PG8_SB(b, h) ((4 + (b) * 2 + (h)) * HTB)
#define PG8_STAGE(bufoff, gbase, voff) do { _Pragma("unroll") for (int _i = 0; _i < 2; ++_i) \
        __builtin_amdgcn_global_load_lds((const unsigned*)((const char*)(gbase) + (voff)[_i]), (PG8_LAS unsigned*)(lds + (bufoff) + ldsw + _i * 8192), 16, 0, 0); } while (0)
#define PG8_LDA(dst, b, h) do { _Pragma("unroll") for (int m = 0; m < 4; ++m) _Pragma("unroll") for (int k = 0; k < 2; ++k) dst[m][k] = *(const PG8_LAS bf16x8*)(lds + PG8_SA(b, h) + aoff + m * 2048 + k * 1024); } while (0)
#define PG8_LDB(dst, b, h) do { _Pragma("unroll") for (int n = 0; n < 2; ++n) _Pragma("unroll") for (int k = 0; k < 2; ++k) dst[n][k] = *(const PG8_LAS bf16x8*)(lds + PG8_SB(b, h) + boff + n * 2048 + k * 1024); } while (0)
#define PG8_MMA(ai, bj, At, Bt) do { __builtin_amdgcn_s_setprio(1); _Pragma("unroll") for (int m = 0; m < 4; ++m) _Pragma("unroll") for (int n = 0; n < 2; ++n) _Pragma("unroll") for (int k = 0; k < 2; ++k) \
        acc[ai][bj][m][n] = __builtin_amdgcn_mfma_f32_16x16x32_bf16(Bt[n][k], At[m][k], acc[ai][bj][m][n], 0, 0, 0); __builtin_amdgcn_s_setprio(0); } while (0)
#define PG8_WAIT_V(n) asm volatile("s_waitcnt vmcnt(" #n ")" ::: "memory")
#define PG8_WAIT_L(n) asm volatile("s_waitcnt lgkmcnt(" #n ")" ::: "memory")
#define PG8_BAR __builtin_amdgcn_s_barrier()
#define PG8_SCHED __builtin_amdgcn_sched_barrier(0)
    Unit cur, nxt; int ui = 0;
    if (!S.next(0, cur)) return;
    f32x4 acc[2][2][4][2];
#pragma unroll
    for (int a = 0; a < 2; ++a)
#pragma unroll
        for (int b = 0; b < 2; ++b)
#pragma unroll
            for (int m = 0; m < 4; ++m)
#pragma unroll
                for (int n = 0; n < 2; ++n) acc[a][b][m][n] = (f32x4){0.f, 0.f, 0.f, 0.f};
    bf16x8 At[4][2], B0[2][2], B1[2][2];
    const char* cA = (const char*)g.A + (size_t)cur.pm * tstep; const char* cB = (const char*)g.Bt + (size_t)cur.pn * tstep;
    S.a_ready(cur);
    PG8_STAGE(PG8_SB(0, 0), cB, voffB); PG8_STAGE(PG8_SA(0, 0), cA, voffA); PG8_STAGE(PG8_SB(0, 1), cB + hstep, voffB); PG8_STAGE(PG8_SA(0, 1), cA + hstep, voffA);
    if (wr == 1) PG8_BAR;
    PG8_WAIT_V(4); PG8_BAR;
    PG8_STAGE(PG8_SB(1, 0), cB + kstep, voffB); PG8_STAGE(PG8_SA(1, 0), cA + kstep, voffA); PG8_STAGE(PG8_SB(1, 1), cB + hstep + kstep, voffB);
    PG8_WAIT_V(6); PG8_BAR;
    for (;;) {
        const bool has_next = S.next(ui + 1, nxt);
        const char* nA = has_next ? (const char*)g.A + (size_t)nxt.pm * tstep : cA; const char* nB = has_next ? (const char*)g.Bt + (size_t)nxt.pn * tstep : cB;
        for (int t = 0; t < nt; t += 2) {
            const bool last = (t == nt - 2);
            const char* a1 = cA + (size_t)(t + 1) * kstep;
            const char* a2 = last ? nA : cA + (size_t)(t + 2) * kstep; const char* b2 = last ? nB : cB + (size_t)(t + 2) * kstep;
            const char* a3 = a2 + kstep; const char* b3 = b2 + kstep;
            if (last && has_next) S.a_ready(nxt);
            PG8_LDB(B0, 0, 0); PG8_SCHED; PG8_LDA(At, 0, 0); PG8_STAGE(PG8_SA(1, 1), a1 + hstep, voffA);
            PG8_WAIT_L(8); PG8_BAR; PG8_WAIT_L(0); PG8_MMA(0, 0, At, B0); PG8_BAR; PG8_SCHED;
            PG8_LDB(B1, 0, 1); PG8_STAGE(PG8_SB(0, 0), b2, voffB);
            PG8_BAR; PG8_WAIT_L(0); PG8_MMA(0, 1, At, B1); PG8_BAR;
            PG8_LDA(At, 0, 1); PG8_STAGE(PG8_SA(0, 0), a2, voffA);
            PG8_BAR; PG8_WAIT_L(0); PG8_MMA(1, 0, At, B0); PG8_BAR; PG8_SCHED;
            PG8_STAGE(PG8_SB(0, 1), b2 + hstep, voffB);
            PG8_WAIT_V(6); PG8_BAR; PG8_MMA(1, 1, At, B1); PG8_BAR;
            PG8_LDB(B0, 1, 0); PG8_SCHED; PG8_LDA(At, 1, 0); PG8_STAGE(PG8_SA(0, 1), a2 + hstep, voffA);
            PG8_WAIT_L(8); PG8_BAR; PG8_WAIT_L(0); PG8_MMA(0, 0, At, B0); PG8_BAR; PG8_SCHED;
            PG8_LDB(B1, 1, 1); PG8_STAGE(PG8_SB(1, 0), b3, voffB);
            PG8_BAR; PG8_WAIT_L(0); PG8_MMA(0, 1, At, B1); PG8_BAR;
            PG8_LDA(At, 1, 1); PG8_STAGE(PG8_SA(1, 0), a3, voffA);
            PG8_BAR; PG8_WAIT_L(0); PG8_MMA(1, 0, At, B0); PG8_BAR; PG8_SCHED;
            PG8_STAGE(PG8_SB(1, 1), b3 + hstep, voffB);
            PG8_WAIT_V(6); PG8_BAR; PG8_MMA(1, 1, At, B1); PG8_BAR;
        }
        if constexpr (!Epi::AFTER_DRAIN) { E(acc, cur, wr, wc, fr, fq); S.done(cur); }
        if (!has_next) break;
#pragma unroll
        for (int a = 0; a < 2; ++a)
#pragma unroll
            for (int b = 0; b < 2; ++b)
#pragma unroll
                for (int m = 0; m < 4; ++m)
#pragma unroll
                    for (int n = 0; n < 2; ++n) acc[a][b][m][n] = (f32x4){0.f, 0.f, 0.f, 0.f};
        cur = nxt; cA = nA; cB = nB; ++ui;
    }
    PG8_WAIT_V(0);
    if (wr == 0) PG8_BAR;
    PG8_BAR;
    if constexpr (Epi::AFTER_DRAIN) { E.fused(acc, cur, wr, wc, fr, fq, lds, wid, lane); S.done(cur); }
#undef PG8_SA
#undef PG8_SB
#undef PG8_STAGE
#undef PG8_LDA
#undef PG8_LDB
#undef PG8_MMA
#undef PG8_WAIT_V
#undef PG8_WAIT_L
#undef PG8_BAR
#undef PG8_SCHED
}
}
using pg8::bf16_t; using pg8::bf16x8; using pg8::f32x4; using pg8::u32x4; using pg8::Unit;
#define LAS __attribute__((address_space(3)))
typedef unsigned u32x2 __attribute__((ext_vector_type(2)));

constexpr int T_ = 8192, D_ = 2048, NP_ = 6144, NPF_ = 6152, DFF_ = 5632, NUP_ = 11264, DPLE_ = 256, SEQ_ = 2048;
constexpr float EPS_ = 1e-6f;
constexpr size_t MiB = (size_t)1 << 20;
constexpr size_t WS_SMALL = 0, WS_WPG = 3 * MiB, WS_WDOWN = 11 * MiB, WS_PP = 33 * MiB,
                 WS_PROJ = 65 * MiB, WS_WOUT = 161 * MiB, WS_WPP = 169 * MiB, WS_PB = 170 * MiB,
                 WS_UP = 65 * MiB, WS_X2B = 65 * MiB, WS_WUP = 241 * MiB, WS_X1B = 285 * MiB, WS_WIN = 285 * MiB,
                 WS_XB = 317 * MiB, WS_Y = 285 * MiB, WS_ACT = 241 * MiB, WS_X3B = 65 * MiB, WS_X2B2 = 100 * MiB, WS_END = 349 * MiB;
constexpr size_t OUT_PB = (size_t)T_ * D_, OUT_WPP = (size_t)T_ * D_ + (size_t)T_ * DPLE_;
constexpr size_t SM_RSTD0 = 0, SM_GATES = 64 * 1024, SM_ACUM = 320 * 1024, SM_MRUN = 448 * 1024, SM_BCUM = 576 * 1024, SM_CNT = 704 * 1024, SM_BAR = 960 * 1024, SM_SSA = 1 * MiB, SM_SSB = 2 * MiB;
constexpr int LDS_BYTES = 131072 + 1024;

struct Params { const float* in[18]; float* out; unsigned char* ws; int ph_lo, ph_hi; };

__device__ __forceinline__ unsigned pk_bf16(float lo, float hi) { unsigned r; asm("v_cvt_pk_bf16_f32 %0, %1, %2" : "=v"(r) : "v"(lo), "v"(hi)); return r; }
__device__ __forceinline__ float bflo(unsigned w) { return __uint_as_float(w << 16); }
__device__ __forceinline__ float bfhi(unsigned w) { return __uint_as_float(w & 0xffff0000u); }
__device__ __forceinline__ float sigm(float x) { return __builtin_amdgcn_rcpf(1.0f + __expf(-x)); }
__device__ __forceinline__ float wave_sum(float v) {
#pragma unroll
    for (int o = 32; o; o >>= 1) v += __shfl_xor(v, o);
    return v;
}
__device__ __forceinline__ void unpack8(const u32x4 w, float (&f)[8]) {
    f[0] = bflo(w.x); f[1] = bfhi(w.x); f[2] = bflo(w.y); f[3] = bfhi(w.y); f[4] = bflo(w.z); f[5] = bfhi(w.z); f[6] = bflo(w.w); f[7] = bfhi(w.w);
}
__device__ __forceinline__ u32x4 pack8(const float (&f)[8]) { u32x4 w; w.x = pk_bf16(f[0], f[1]); w.y = pk_bf16(f[2], f[3]); w.z = pk_bf16(f[4], f[5]); w.w = pk_bf16(f[6], f[7]); return w; }

struct TileDesc { const float* src; bf16_t* dst; const float* gk; int N, ldt, k0, n0; float cs; };
__device__ __forceinline__ TileDesc tile_desc(const Params& p, int l) {
    constexpr int NT_IN = 32 * 96, NT_PP = 4 * 32, NT_OUT = 32 * 32, NT_UP = 32 * 176, NT_DOWN = 88 * 32;
    unsigned char* ws = p.ws; TileDesc d; d.cs = 1.0f; d.gk = nullptr; int ntn;
    if (l < NT_IN) { ntn = 96; d.src = p.in[3]; d.N = NPF_; d.dst = (bf16_t*)(ws + WS_WIN); d.ldt = D_; d.gk = p.in[2]; const int nt = l % 96; if (nt >= 48 && nt < 56) d.cs = 0.08838834764831845f; }
    else if ((l -= NT_IN) < NT_PP) { ntn = 32; d.src = p.in[16]; d.N = D_; d.dst = (bf16_t*)p.out + OUT_WPP; d.ldt = DPLE_; }
    else if ((l -= NT_PP) < NT_OUT) { ntn = 32; d.src = p.in[8]; d.N = D_; d.dst = (bf16_t*)(ws + WS_WOUT); d.ldt = D_; }
    else if ((l -= NT_OUT) < NT_UP) { ntn = 176; d.src = p.in[10]; d.N = NUP_; d.dst = (bf16_t*)(ws + WS_WUP); d.ldt = D_; d.gk = p.in[9]; }
    else if ((l -= NT_UP) < NT_DOWN) { ntn = 32; d.src = p.in[13]; d.N = D_; d.dst = (bf16_t*)(ws + WS_WDOWN); d.ldt = DFF_; }
    else { l -= NT_DOWN; ntn = 32; d.src = p.in[15]; d.N = D_; d.dst = (bf16_t*)(ws + WS_WPG); d.ldt = D_; d.gk = p.in[14]; }
    d.n0 = (l % ntn) * 64; d.k0 = (l / ntn) * 64; return d;
}

constexpr int NT_EARLY = 32 * 96 + 4 * 32 + 32 * 32 + 32 * 176;
constexpr int NT_ALL = NT_EARLY + 88 * 32 + 32 * 32;
__device__ void convert_tiles(const Params& p, LAS unsigned char* lds, const int first, const int last, const int worker, const int nworkers, const int wv) {
    const int tid = TID_X;
    const int n4 = tid & 15, kp = tid >> 4, r = tid >> 3, c = tid & 7;
    for (int i4 = first + worker * 4; i4 < last; i4 += nworkers * 4) {
        f32x4 a[4], b[4]; float g0[4], g1[4];
#pragma unroll
        for (int u = 0; u < 4; ++u) {
            const TileDesc d = tile_desc(p, i4 + u);
            const float* src = d.src + (size_t)(d.k0 + 2 * kp) * d.N + d.n0 + 4 * n4;
            a[u] = __builtin_nontemporal_load((const f32x4*)src); b[u] = __builtin_nontemporal_load((const f32x4*)(src + d.N));
            g0[u] = d.cs; g1[u] = d.cs;
            if (d.gk) { g0[u] *= d.gk[d.k0 + 2 * kp]; g1[u] *= d.gk[d.k0 + 2 * kp + 1]; }
        }
        __syncthreads();
#pragma unroll
        for (int u = 0; u < 4; ++u) {
            LAS unsigned* l32 = (LAS unsigned*)(lds + u * 8448);
#pragma unroll
            for (int j = 0; j < 4; ++j) l32[(4 * n4 + j) * 33 + kp] = pk_bf16(a[u][j] * g0[u], b[u][j] * g1[u]);
        }
        __syncthreads();
#pragma unroll
        for (int u = 0; u < 4; ++u) {
            const TileDesc d = tile_desc(p, i4 + u);
            LAS unsigned* l32 = (LAS unsigned*)(lds + u * 8448);
            u32x4 o; o.x = l32[r * 33 + 4 * c]; o.y = l32[r * 33 + 4 * c + 1]; o.z = l32[r * 33 + 4 * c + 2]; o.w = l32[r * 33 + 4 * c + 3];
            *(u32x4*)(d.dst + (size_t)(d.n0 + r) * d.ldt + d.k0 + 8 * c) = o;
        }
    }
}

__device__ void phase_prep(const Params& p, LAS unsigned char* lds, const int wv) {
    const int wid = wv, lane = lane_id(), tid = wv * 64 + lane;
    unsigned char* ws = p.ws;
    convert_tiles(p, lds, 0, NT_EARLY, blockIdx.x, gridDim.x, wv);
    __syncthreads();
    LAS float* wg = (LAS float*)(lds + 32768);
    for (int i = tid; i < 2048 * 2; i += 512) {
        const int k = i >> 1, hf = i & 1;
        f32x4 v = *(const f32x4*)(p.in[3] + (size_t)k * NPF_ + NP_ + 4 * hf);
        const float g = p.in[2][k];
#pragma unroll
        for (int j = 0; j < 4; ++j) wg[(4 * hf + j) * 2048 + k] = v[j] * g;
    }
    __syncthreads();
    bf16_t* xb = (bf16_t*)(ws + WS_XB);
    float* rstd0 = (float*)(ws + WS_SMALL + SM_RSTD0);
    float* gates = (float*)(ws + WS_SMALL + SM_GATES);
    for (int row = blockIdx.x * 8 + wid; row < T_; row += gridDim.x * 8) {
        const float* xr = p.in[0] + (size_t)row * D_;
        float ss = 0.f, dots[8];
#pragma unroll
        for (int j = 0; j < 8; ++j) dots[j] = 0.f;
#pragma unroll
        for (int i = 0; i < 8; ++i) {
            const int k = (i * 64 + lane) * 4;
            const f32x4 v = __builtin_nontemporal_load((const f32x4*)(xr + k));
            ss += v.x * v.x + v.y * v.y + v.z * v.z + v.w * v.w;
            u32x2 o; o.x = pk_bf16(v.x, v.y); o.y = pk_bf16(v.z, v.w);
            *(u32x2*)(xb + (size_t)row * D_ + k) = o;
#pragma unroll
            for (int j = 0; j < 8; ++j) { const f32x4 w = *(const LAS f32x4*)(wg + j * 2048 + k); dots[j] += v.x * w.x + v.y * w.y + v.z * w.z + v.w * w.w; }
        }
        ss = wave_sum(ss);
#pragma unroll
        for (int j = 0; j < 8; ++j) dots[j] = wave_sum(dots[j]);
        const float rs = rsqrtf(ss * (1.0f / D_) + EPS_);
        if (lane == 0) rstd0[row] = rs;
        if (lane < 8) {
            float d = dots[0];
#pragma unroll
            for (int j = 1; j < 8; ++j) d = (lane == j) ? dots[j] : d;
            const float bias = (lane < 4) ? p.in[4][lane & 3] : p.in[5][lane & 3];
            gates[(size_t)row * 8 + lane] = rs * d + bias;
        }
    }
    {
        bf16_t* pb = (bf16_t*)p.out + OUT_PB;
        const size_t n4 = (size_t)T_ * DPLE_ / 4;
        for (size_t i = (size_t)blockIdx.x * 512 + tid; i < n4; i += (size_t)gridDim.x * 512) {
            const f32x4 v = __builtin_nontemporal_load((const f32x4*)(p.in[1] + i * 4));
            u32x2 o; o.x = pk_bf16(v.x, v.y); o.y = pk_bf16(v.z, v.w);
            *(u32x2*)(pb + i * 4) = o;
        }
    }
}

#define DPPF(old, x, ctrl, rmask) __builtin_bit_cast(float, __builtin_amdgcn_update_dpp(__builtin_bit_cast(int, (float)(old)), __builtin_bit_cast(int, (float)(x)), ctrl, rmask, 0xf, false))
__device__ __forceinline__ float wave_scan_add(float v) {
    v += DPPF(0.f, v, 0x111, 0xf); v += DPPF(0.f, v, 0x112, 0xf); v += DPPF(0.f, v, 0x114, 0xf); v += DPPF(0.f, v, 0x118, 0xf);
    v += DPPF(0.f, v, 0x142, 0xa); v += DPPF(0.f, v, 0x143, 0xc);
    return v;
}
__device__ __forceinline__ float wave_scan_max(float v) {
    const float ninf = -__builtin_inff();
    v = fmaxf(v, DPPF(ninf, v, 0x111, 0xf)); v = fmaxf(v, DPPF(ninf, v, 0x112, 0xf)); v = fmaxf(v, DPPF(ninf, v, 0x114, 0xf)); v = fmaxf(v, DPPF(ninf, v, 0x118, 0xf));
    v = fmaxf(v, DPPF(ninf, v, 0x142, 0xa)); v = fmaxf(v, DPPF(ninf, v, 0x143, 0xc));
    return v;
}
__device__ void scan_gates(const float* gates, float* acum, float* mrun, float* bcum, int bh, int lane) {
    const int batch = bh >> 2, h = bh & 3;
    float fgv[32], igv[32];
#pragma unroll
    for (int r = 0; r < 32; ++r) { const size_t t = (size_t)batch * SEQ_ + r * 64 + lane; fgv[r] = gates[t * 8 + 4 + h]; igv[r] = gates[t * 8 + h]; }
    float carryB = 0.f, carryM = 0.f;
#pragma unroll
    for (int r = 0; r < 32; ++r) {
        const int s = r * 64 + lane;
        const float fg = fgv[r], ig = igv[r];
        const float lf = -(fmaxf(-fg, 0.f) + log1pf(expf(-fabsf(fg))));
        const float B = carryB + wave_scan_add(lf);
        const float a = ig - B;
        const float M = fmaxf(carryM, wave_scan_max(a));
        acum[bh * SEQ_ + s] = a; mrun[bh * SEQ_ + s] = M; bcum[bh * SEQ_ + s] = B;
        carryB = __builtin_bit_cast(float, __builtin_amdgcn_readlane(__builtin_bit_cast(int, B), 63));
        carryM = __builtin_bit_cast(float, __builtin_amdgcn_readlane(__builtin_bit_cast(int, M), 63));
    }
}

#define SCHED_FENCE() __builtin_amdgcn_sched_barrier(0)
__device__ __forceinline__ void store_bf16_rows(const f32x4 (&acc)[2][2][4][2], bf16_t* O, int ldc, int row0, int col0, const float (&rs)[2][4]) {
#pragma unroll
    for (int ai = 0; ai < 2; ++ai)
#pragma unroll
        for (int m = 0; m < 4; ++m) {
            bf16_t* rowp = O + (size_t)(row0 + ai * 128 + m * 16) * ldc + col0;
            const float r = rs[ai][m];
#pragma unroll
            for (int bj = 0; bj < 2; ++bj) {
                const f32x4 v0 = acc[ai][bj][m][0] * r, v1 = acc[ai][bj][m][1] * r;
                u32x4 w; w.x = pk_bf16(v0[0], v0[1]); w.y = pk_bf16(v0[2], v0[3]); w.z = pk_bf16(v1[0], v1[1]); w.w = pk_bf16(v1[2], v1[3]);
                *(u32x4*)(rowp + bj * 128) = w;
            }
        }
}
struct EpiBf16Scale {
    static constexpr bool PERM = true, AFTER_DRAIN = false;
    bf16_t* O; int ldc; const float* rowscale;
    __device__ __forceinline__ void operator()(const f32x4 (&acc)[2][2][4][2], const Unit& u, int wr, int wc, int fr, int fq) const {
        const int row0 = u.pm * 256 + wr * 64 + fr, col0 = u.pn * 256 + wc * 32 + 8 * fq;
        float rs[2][4];
#pragma unroll
        for (int ai = 0; ai < 2; ++ai)
#pragma unroll
            for (int m = 0; m < 4; ++m) rs[ai][m] = rowscale ? rowscale[row0 + ai * 128 + m * 16] : 1.0f;
        SCHED_FENCE();
        store_bf16_rows(acc, O, ldc, row0, col0, rs);
    }
};
__device__ __forceinline__ void rstd_rows(const float* ss, int row0, int fq, float (&rs)[2][4]) {
    f32x4 a[2][4], b[2][4];
#pragma unroll
    for (int ai = 0; ai < 2; ++ai)
#pragma unroll
        for (int m = 0; m < 4; ++m) { const float* q = ss + (size_t)(row0 + ai * 128 + m * 16) * 32 + 8 * fq; a[ai][m] = *(const f32x4*)q; b[ai][m] = *(const f32x4*)(q + 4); }
    SCHED_FENCE();
#pragma unroll
    for (int ai = 0; ai < 2; ++ai)
#pragma unroll
        for (int m = 0; m < 4; ++m) {
            const f32x4 x = a[ai][m], y = b[ai][m];
            float t = ((x.x + x.y) + (x.z + x.w)) + ((y.x + y.y) + (y.z + y.w));
            t += __shfl_xor(t, 16); t += __shfl_xor(t, 32);
            rs[ai][m] = rsqrtf(t * (1.0f / D_) + EPS_);
        }
}
struct EpiBf16Norm {
    static constexpr bool PERM = true, AFTER_DRAIN = false;
    bf16_t* O; int ldc; const float* ss;
    __device__ __forceinline__ void operator()(const f32x4 (&acc)[2][2][4][2], const Unit& u, int wr, int wc, int fr, int fq) const {
        const int row0 = u.pm * 256 + wr * 64 + fr, col0 = u.pn * 256 + wc * 32 + 8 * fq;
        float rs[2][4];
        rstd_rows(ss, row0, fq, rs);
        SCHED_FENCE();
        store_bf16_rows(acc, O, ldc, row0, col0, rs);
    }
};
struct EpiResidBf {
    static constexpr bool PERM = true, AFTER_DRAIN = false;
    const bf16_t* base; bf16_t* ob; float* ssout;
    __device__ __forceinline__ void operator()(const f32x4 (&acc)[2][2][4][2], const Unit& u, int wr, int wc, int fr, int fq) const {
        const int row0 = u.pm * 256 + wr * 64 + fr, col0 = u.pn * 256 + wc * 32 + 8 * fq;
        u32x4 r[4][2];
#define ER_LOAD(q) do { const size_t off_ = (size_t)(row0 + ((q) >> 2) * 128 + ((q) & 3) * 16) * D_ + col0; r[(q) & 3][0] = *(const u32x4*)(base + off_); r[(q) & 3][1] = *(const u32x4*)(base + off_ + 128); } while (0)
        ER_LOAD(0); ER_LOAD(1); ER_LOAD(2);
#pragma unroll
        for (int q = 0; q < 8; ++q) {
            const int ai = q >> 2, m = q & 3;
            if (q + 3 < 8) ER_LOAD(q + 3);
            SCHED_FENCE();
            const int row = row0 + ai * 128 + m * 16;
            const size_t off = (size_t)row * D_ + col0;
            float s = 0.f;
#pragma unroll
            for (int bj = 0; bj < 2; ++bj) {
                float f[8]; unpack8(r[q & 3][bj], f);
                const f32x4 v0 = acc[ai][bj][m][0] + (f32x4){f[0], f[1], f[2], f[3]}, v1 = acc[ai][bj][m][1] + (f32x4){f[4], f[5], f[6], f[7]};
                u32x4 w; w.x = pk_bf16(v0[0], v0[1]); w.y = pk_bf16(v0[2], v0[3]); w.z = pk_bf16(v1[0], v1[1]); w.w = pk_bf16(v1[2], v1[3]);
                *(u32x4*)(ob + off + bj * 128) = w;
                s += (v0[0] * v0[0] + v0[1] * v0[1]) + (v0[2] * v0[2] + v0[3] * v0[3]) + (v1[0] * v1[0] + v1[1] * v1[1]) + (v1[2] * v1[2] + v1[3] * v1[3]);
            }
            s += __shfl_xor(s, 16); s += __shfl_xor(s, 32);
            if (fq == 0) ssout[(size_t)row * 32 + u.pn * 4 + wc] = s;
            SCHED_FENCE();
        }
#undef ER_LOAD
    }
};
struct EpiPleGateBf {
    static constexpr bool PERM = true, AFTER_DRAIN = false;
    const bf16_t* base; bf16_t* ob; const bf16_t* pp; const float* ssin; float* ssout;
    __device__ __forceinline__ void operator()(const f32x4 (&acc)[2][2][4][2], const Unit& u, int wr, int wc, int fr, int fq) const {
        const int row0 = u.pm * 256 + wr * 64 + fr, col0 = u.pn * 256 + wc * 32 + 8 * fq;
        float rs[2][4];
        rstd_rows(ssin, row0, fq, rs);
        u32x4 r[2][2], pw[2][2];
#define EP_LOAD(slot, q) do { const size_t off_ = (size_t)(row0 + ((q) >> 2) * 128 + ((q) & 3) * 16) * D_ + col0; \
            r[slot][0] = *(const u32x4*)(base + off_); r[slot][1] = *(const u32x4*)(base + off_ + 128); \
            pw[slot][0] = *(const u32x4*)(pp + off_); pw[slot][1] = *(const u32x4*)(pp + off_ + 128); } while (0)
        EP_LOAD(0, 0);
#pragma unroll
        for (int q = 0; q < 8; ++q) {
            const int ai = q >> 2, m = q & 3, sl = q & 1;
            if (q + 1 < 8) EP_LOAD((q + 1) & 1, q + 1);
            SCHED_FENCE();
            const int row = row0 + ai * 128 + m * 16;
            const size_t off = (size_t)row * D_ + col0;
            const float rsv = rs[ai][m];
            float s = 0.f;
#pragma unroll
            for (int bj = 0; bj < 2; ++bj) {
                float pf[8], xf[8]; unpack8(pw[sl][bj], pf); unpack8(r[sl][bj], xf);
                f32x4 v0, v1;
#pragma unroll
                for (int j = 0; j < 4; ++j) { v0[j] = xf[j] + sigm(acc[ai][bj][m][0][j] * rsv) * pf[j]; v1[j] = xf[4 + j] + sigm(acc[ai][bj][m][1][j] * rsv) * pf[4 + j]; }
                u32x4 w; w.x = pk_bf16(v0[0], v0[1]); w.y = pk_bf16(v0[2], v0[3]); w.z = pk_bf16(v1[0], v1[1]); w.w = pk_bf16(v1[2], v1[3]);
                *(u32x4*)(ob + off + bj * 128) = w;
                s += (v0[0] * v0[0] + v0[1] * v0[1]) + (v0[2] * v0[2] + v0[3] * v0[3]) + (v1[0] * v1[0] + v1[1] * v1[1]) + (v1[2] * v1[2] + v1[3] * v1[3]);
            }
            s += __shfl_xor(s, 16); s += __shfl_xor(s, 32);
            if (fq == 0) ssout[(size_t)row * 32 + u.pn * 4 + wc] = s;
            SCHED_FENCE();
        }
#undef EP_LOAD
    }
};

struct EpiPleFinal {
    static constexpr bool PERM = true, AFTER_DRAIN = true, APERM = false;
    const bf16_t* base; const bf16_t* pp; const float* ssin; float* ssx; unsigned* cnt; const float* gf; float* out;
    __device__ __forceinline__ void fused(const f32x4 (&acc)[2][2][4][2], const Unit& u, int wr, int wc, int fr, int fq, LAS unsigned char*, int, int) const {
        const int row0 = u.pm * 256 + wr * 64 + fr, col0 = u.pn * 256 + wc * 32 + 8 * fq;
        float rs[2][4];
        rstd_rows(ssin, row0, fq, rs);
        u32x4 xk[8][2];
        u32x4 r[2][2], pw[2][2];
#define EP_LOAD(slot, q) do { const size_t off_ = (size_t)(row0 + ((q) >> 2) * 128 + ((q) & 3) * 16) * D_ + col0; \
            r[slot][0] = *(const u32x4*)(base + off_); r[slot][1] = *(const u32x4*)(base + off_ + 128); \
            pw[slot][0] = *(const u32x4*)(pp + off_); pw[slot][1] = *(const u32x4*)(pp + off_ + 128); } while (0)
        EP_LOAD(0, 0);
#pragma unroll
        for (int q = 0; q < 8; ++q) {
            const int ai = q >> 2, m = q & 3, sl = q & 1;
            if (q + 1 < 8) EP_LOAD((q + 1) & 1, q + 1);
            SCHED_FENCE();
            const int row = row0 + ai * 128 + m * 16;
            const float rsv = rs[ai][m];
            float s = 0.f;
#pragma unroll
            for (int bj = 0; bj < 2; ++bj) {
                float pf[8], xf[8]; unpack8(pw[sl][bj], pf); unpack8(r[sl][bj], xf);
                f32x4 v0, v1;
#pragma unroll
                for (int j = 0; j < 4; ++j) { v0[j] = xf[j] + sigm(acc[ai][bj][m][0][j] * rsv) * pf[j]; v1[j] = xf[4 + j] + sigm(acc[ai][bj][m][1][j] * rsv) * pf[4 + j]; }
                u32x4 w; w.x = pk_bf16(v0[0], v0[1]); w.y = pk_bf16(v0[2], v0[3]); w.z = pk_bf16(v1[0], v1[1]); w.w = pk_bf16(v1[2], v1[3]);
                xk[q][bj] = w;
                s += (v0[0] * v0[0] + v0[1] * v0[1]) + (v0[2] * v0[2] + v0[3] * v0[3]) + (v1[0] * v1[0] + v1[1] * v1[1]) + (v1[2] * v1[2] + v1[3] * v1[3]);
            }
            s += __shfl_xor(s, 16); s += __shfl_xor(s, 32);
            if (fq == 0) __hip_atomic_store(ssx + (size_t)row * 32 + u.pn * 4 + wc, s, __ATOMIC_RELAXED, __HIP_MEMORY_SCOPE_AGENT);
            SCHED_FENCE();
        }
#undef EP_LOAD
        asm volatile("s_waitcnt vmcnt(0)" ::: "memory");
        unsigned* const c = cnt + 64 * u.pm;
        if (fr == 0 && fq == 0) __hip_atomic_fetch_add(c, 1u, __ATOMIC_RELAXED, __HIP_MEMORY_SCOPE_AGENT);
        if (wr == 0 && wc == 0) {
            for (unsigned spins = 0; spins < (1u << 22); ++spins) {
                if ((unsigned)__builtin_amdgcn_readfirstlane((int)__hip_atomic_load(c, __ATOMIC_RELAXED, __HIP_MEMORY_SCOPE_AGENT)) >= 64u) break;
                __builtin_amdgcn_s_sleep(1);
            }
            __builtin_amdgcn_fence(__ATOMIC_ACQUIRE, "agent");
            asm volatile("s_waitcnt vmcnt(0)" ::: "memory");
        }
        __builtin_amdgcn_s_barrier();
        asm volatile("" ::: "memory");
        float rs3[2][4];
        rstd_rows(ssx, row0, fq, rs3);
        f32x4 gfv[2][2];
#pragma unroll
        for (int bj = 0; bj < 2; ++bj) { gfv[bj][0] = *(const f32x4*)(gf + col0 + bj * 128); gfv[bj][1] = *(const f32x4*)(gf + col0 + bj * 128 + 4); }
#pragma unroll
        for (int q = 0; q < 8; ++q) {
            const int ai = q >> 2, m = q & 3;
            const size_t off = (size_t)(row0 + ai * 128 + m * 16) * D_ + col0;
            const float rv = rs3[ai][m];
#pragma unroll
            for (int bj = 0; bj < 2; ++bj) {
                float f[8]; unpack8(xk[q][bj], f);
                *(f32x4*)(out + off + bj * 128) = (f32x4){f[0], f[1], f[2], f[3]} * rv * gfv[bj][0];
                *(f32x4*)(out + off + bj * 128 + 4) = (f32x4){f[4], f[5], f[6], f[7]} * rv * gfv[bj][1];
            }
        }
    }
};

__device__ void phase_convgroup(const Params& p, const int wv) {
    const bf16_t* proj = (const bf16_t*)(p.ws + WS_PROJ);
    bf16_t* y = (bf16_t*)(p.ws + WS_Y);
    const float* cw = p.in[6];
    for (int it = blockIdx.x * 512 + TID_X; it < (T_ / 8) * 128; it += gridDim.x * 512) {
        const int cc = it & 127, run = it >> 7, c = cc * 8, t0 = run * 8;
        float w0[8], w1[8], w2[8], p2[8], p1[8];
#pragma unroll
        for (int j = 0; j < 8; ++j) { w0[j] = cw[c + j]; w1[j] = cw[1024 + c + j]; w2[j] = cw[2048 + c + j]; p2[j] = 0.f; p1[j] = 0.f; }
        if ((t0 & (SEQ_ - 1)) != 0) {
            float a[8], b[8];
            unpack8(*(const u32x4*)(proj + (size_t)(t0 - 2) * NP_ + 1024 + c), a); unpack8(*(const u32x4*)(proj + (size_t)(t0 - 2) * NP_ + 2048 + c), b);
#pragma unroll
            for (int j = 0; j < 8; ++j) p2[j] = a[j] * b[j];
            unpack8(*(const u32x4*)(proj + (size_t)(t0 - 1) * NP_ + 1024 + c), a); unpack8(*(const u32x4*)(proj + (size_t)(t0 - 1) * NP_ + 2048 + c), b);
#pragma unroll
            for (int j = 0; j < 8; ++j) p1[j] = a[j] * b[j];
        }
#pragma unroll
        for (int dt = 0; dt < 8; ++dt) {
            const size_t ro = (size_t)(t0 + dt) * NP_;
            float gb[8], gc[8], uu[8], o[8];
            unpack8(*(const u32x4*)(proj + ro + c), gb); unpack8(*(const u32x4*)(proj + ro + 1024 + c), gc); unpack8(*(const u32x4*)(proj + ro + 2048 + c), uu);
#pragma unroll
            for (int j = 0; j < 8; ++j) { const float cur = gc[j] * uu[j]; o[j] = gb[j] * (w0[j] * p2[j] + w1[j] * p1[j] + w2[j] * cur); p2[j] = p1[j]; p1[j] = cur; }
            *(u32x4*)(y + (size_t)(t0 + dt) * D_ + c) = pack8(o);
        }
    }
}

constexpr int ML_KOFF = 0, ML_KSZ = 64 * 288, ML_VOFF = 2 * ML_KSZ, ML_VSZ = 256 * 160, ML_AOFF = ML_VOFF + 2 * ML_VSZ, ML_AROFF = ML_AOFF + 512, ML_SSOFF = ML_AROFF + 512;
__device__ __forceinline__ void ml_compute(LAS unsigned char* lds, const int buf, const bool diag, const int tl, const int g, const int tb, const int vh,
                                           const bf16x8 (&qf)[4], const float Mt, const float amax, f32x4 (&oacc)[8], float& den) {
    constexpr int KOFF = ML_KOFF, KSZ = ML_KSZ, VOFF = ML_VOFF, VSZ = ML_VSZ, AOFF = ML_AOFF, AROFF = ML_AROFF;
    LAS unsigned char* const kfb = lds + tl * 288 + g * 16;
    LAS unsigned char* const afb = lds + g * 16;
    LAS unsigned char* const vfb0 = lds + (vh * 128 + tl) * 160 + g * 16;
                u32x4 pf[2];
                f32x4 sa[4];
#pragma unroll
                for (int sh = 0; sh < 2; ++sh) {
                    bf16x8 kf[2][4];
#pragma unroll
                    for (int s2 = 0; s2 < 2; ++s2)
#pragma unroll
                        for (int kk = 0; kk < 4; ++kk) kf[s2][kk] = *(const LAS bf16x8*)(kfb + (KOFF + buf * KSZ + 16 * (2 * sh + s2) * 288 + 64 * kk));
                    SCHED_FENCE();
                    sa[2 * sh] = (f32x4){0.f, 0.f, 0.f, 0.f}; sa[2 * sh + 1] = (f32x4){0.f, 0.f, 0.f, 0.f};
#pragma unroll
                    for (int kk = 0; kk < 4; ++kk)
#pragma unroll
                        for (int s2 = 0; s2 < 2; ++s2) sa[2 * sh + s2] = __builtin_amdgcn_mfma_f32_16x16x32_bf16(kf[s2][kk], qf[kk], sa[2 * sh + s2], 0, 0, 0);
                    SCHED_FENCE();
                }
                bf16x8 vf[4];
#pragma unroll
                for (int i = 0; i < 4; ++i) { const int nb = i >> 1, k2 = i & 1;
                    vf[i] = *(const LAS bf16x8*)(vfb0 + (VOFF + buf * VSZ + nb * 16 * 160 + k2 * 64)); }
                f32x4 a4[4];
                if (!diag) {
#pragma unroll
                    for (int sb = 0; sb < 4; ++sb) a4[sb] = *(const LAS f32x4*)(afb + (AOFF + buf * 256 + 64 * sb));
                    SCHED_FENCE();
                    const float et = __expf(amax - Mt);
#pragma unroll
                    for (int sb = 0; sb < 4; ++sb) {
                        const f32x4 pv = sa[sb] * (a4[sb] * et);
                        den += (pv[0] + pv[1]) + (pv[2] + pv[3]);
                        const unsigned lo = pk_bf16(pv[0], pv[1]), hi = pk_bf16(pv[2], pv[3]);
                        if (sb & 1) { pf[sb >> 1].z = lo; pf[sb >> 1].w = hi; } else { pf[sb >> 1].x = lo; pf[sb >> 1].y = hi; }
                    }
                } else {
#pragma unroll
                    for (int sb = 0; sb < 4; ++sb) a4[sb] = *(const LAS f32x4*)(afb + (AROFF + buf * 256 + 64 * sb));
                    SCHED_FENCE();
#pragma unroll
                    for (int sb = 0; sb < 4; ++sb) {
                        float pv[4];
#pragma unroll
                        for (int j = 0; j < 4; ++j) {
                            float w = __expf(a4[sb][j] - Mt);
                            if ((16 * sb + 4 * g + j) > (tb * 16 + tl)) w = 0.f;
                            pv[j] = sa[sb][j] * w; den += pv[j];
                        }
                        const unsigned lo = pk_bf16(pv[0], pv[1]), hi = pk_bf16(pv[2], pv[3]);
                        if (sb & 1) { pf[sb >> 1].z = lo; pf[sb >> 1].w = hi; } else { pf[sb >> 1].x = lo; pf[sb >> 1].y = hi; }
                    }
                }
                SCHED_FENCE();
                const bf16x8 pb0 = __builtin_bit_cast(bf16x8, pf[0]), pb1 = __builtin_bit_cast(bf16x8, pf[1]);
#pragma unroll
                for (int qd = 0; qd < 4; ++qd) {
#pragma unroll
                    for (int i = 0; i < 4; ++i) oacc[2 * qd + (i >> 1)] = __builtin_amdgcn_mfma_f32_16x16x32_bf16(vf[i], (i & 1) ? pb1 : pb0, oacc[2 * qd + (i >> 1)], 0, 0, 0);
                    if (qd < 3) {
#pragma unroll
                        for (int i = 0; i < 4; ++i) { const int nb = 2 * (qd + 1) + (i >> 1), k2 = i & 1;
                            vf[i] = *(const LAS bf16x8*)(vfb0 + (VOFF + buf * VSZ + nb * 16 * 160 + k2 * 64)); }
                        SCHED_FENCE();
                    }
                }
}

__device__ void phase_mlstm(const Params& p, LAS unsigned char* lds, const int wv) {
    const int wid = wv, lane = lane_id(), tid = wv * 64 + lane, tl = lane & 15, g = lane >> 4, tb = wid & 3, vh = wid >> 2;
    const bf16_t* proj = (const bf16_t*)(p.ws + WS_PROJ);
    bf16_t* y = (bf16_t*)(p.ws + WS_Y);
    const float* acum = (const float*)(p.ws + WS_SMALL + SM_ACUM);
    const float* mrun = (const float*)(p.ws + WS_SMALL + SM_MRUN);
    const float* bcum = (const float*)(p.ws + WS_SMALL + SM_BCUM);
    constexpr int KOFF = ML_KOFF, KSZ = ML_KSZ, VOFF = ML_VOFF, VSZ = ML_VSZ, AOFF = ML_AOFF, AROFF = ML_AROFF, SSOFF = ML_SSOFF;
    for (int pr = blockIdx.x; pr < 256; pr += gridDim.x) {
        const int xx = pr & 7, jj = pr >> 3;
        const int bh = 2 * xx + (jj >> 4), ip = jj & 15, batch = bh >> 2, h = bh & 3;
        for (int which = 0; which < 2; ++which) {
            const int qi = which ? ip : 31 - ip;
            const int trow = batch * SEQ_ + qi * 64 + tb * 16 + tl;
            const int sidx = bh * SEQ_ + qi * 64 + tb * 16 + tl;
            bf16x8 qf[4];
#pragma unroll
            for (int kk = 0; kk < 4; ++kk) qf[kk] = *(const bf16x8*)(proj + (size_t)trow * NP_ + 3072 + h * 128 + 32 * kk + 8 * g);
            const float Mt = mrun[sidx];
            f32x4 oacc[8];
#pragma unroll
            for (int nb = 0; nb < 8; ++nb) oacc[nb] = (f32x4){0.f, 0.f, 0.f, 0.f};
            float den = 0.f;
            u32x4 kreg[2][2], vreg[2][4]; float areg[2] = {0.f, 0.f}, amaxr[2] = {0.f, 0.f};
            const bf16_t* kbase = proj + (size_t)batch * SEQ_ * NP_ + 3584 + h * 128;
            const bf16_t* vbase = proj + (size_t)batch * SEQ_ * NP_ + 4096 + h * 256;
            const unsigned koff = (unsigned)((tid >> 4) * NP_ + (tid & 15) * 8), voff = (unsigned)(4 * (tid & 15) * NP_ + (tid >> 4) * 8);
#define ML_LOAD(kj, S) do { \
                { const bf16_t* kt_ = kbase + (size_t)(kj) * 64 * NP_; const bf16_t* vt_ = vbase + (size_t)(kj) * 64 * NP_; \
                  kreg[S][0] = *(const u32x4*)(kt_ + koff); kreg[S][1] = *(const u32x4*)(kt_ + 32 * NP_ + koff); \
                  _Pragma("unroll") for (int ii = 0; ii < 4; ++ii) vreg[S][ii] = *(const u32x4*)(vt_ + ii * NP_ + voff); } \
                areg[S] = acum[bh * SEQ_ + (kj) * 64 + (tid & 63)]; } while (0)
#define ML_STORE(buf, S) do { \
                _Pragma("unroll") for (int ii = 0; ii < 2; ++ii) { const int ch = tid + 512 * ii; *(LAS u32x4*)(lds + KOFF + (buf) * KSZ + (ch >> 4) * 288 + (ch & 15) * 16) = kreg[S][ii]; } \
                { const int sq = tid & 15, vc = tid >> 4; \
                  const int grp = ((sq >> 3) << 2) | (sq & 3), half = (sq >> 2) & 1; \
                  LAS unsigned char* vb = lds + VOFF + (buf) * VSZ + (vc * 8) * 160 + (grp << 4) + (half << 3); \
                  _Pragma("unroll") for (int d = 0; d < 4; ++d) { \
                      const unsigned a0 = vreg[S][0][d], a1 = vreg[S][1][d], a2 = vreg[S][2][d], a3 = vreg[S][3][d]; \
                      u32x2 ev, od; ev.x = (a0 & 0xffffu) | (a1 << 16); ev.y = (a2 & 0xffffu) | (a3 << 16); od.x = (a0 >> 16) | (a1 & 0xffff0000u); od.y = (a2 >> 16) | (a3 & 0xffff0000u); \
                      *(LAS u32x2*)(vb + (2 * d) * 160) = ev; *(LAS u32x2*)(vb + (2 * d + 1) * 160) = od; } } \
                { const float mx_ = wave_scan_max(areg[S]); amaxr[S] = __builtin_bit_cast(float, __builtin_amdgcn_readlane(__builtin_bit_cast(int, mx_), 63)); \
                  *(LAS float*)(lds + AOFF + (buf) * 256 + (tid & 63) * 4) = __expf(areg[S] - amaxr[S]); *(LAS float*)(lds + AROFF + (buf) * 256 + (tid & 63) * 4) = areg[S]; } } while (0)
            ML_LOAD(0, 0);
            ML_LOAD(min(1, qi), 1);
            ML_STORE(0, 0);
            __syncthreads();
            for (int kj = 0; kj <= qi; kj += 2) {
                ML_LOAD(min(kj + 2, qi), 0);
                ml_compute(lds, 0, kj == qi, tl, g, tb, vh, qf, Mt, amaxr[0], oacc, den);
                ML_STORE(1, 1);
                __syncthreads();
                if (kj + 1 > qi) break;
                ML_LOAD(min(kj + 3, qi), 1);
                ml_compute(lds, 1, kj + 1 == qi, tl, g, tb, vh, qf, Mt, amaxr[1], oacc, den);
                ML_STORE(0, 0);
                __syncthreads();
            }
#undef ML_LOAD
#undef ML_STORE
            u32x2 owv[8];
#pragma unroll
            for (int nb = 0; nb < 8; ++nb) owv[nb] = *(const u32x2*)(proj + (size_t)trow * NP_ + 5120 + h * 256 + vh * 128 + nb * 16 + 4 * g);
            const float bct = bcum[sidx];
            den += __shfl_xor(den, 16); den += __shfl_xor(den, 32);
            const float mt = bct + Mt;
            const float inv = 1.0f / fmaxf(fabsf(den), __expf(-mt));
            float ssq = 0.f;
#pragma unroll
            for (int nb = 0; nb < 8; ++nb) { oacc[nb] *= inv; ssq += (oacc[nb][0] * oacc[nb][0] + oacc[nb][1] * oacc[nb][1]) + (oacc[nb][2] * oacc[nb][2] + oacc[nb][3] * oacc[nb][3]); }
            ssq += __shfl_xor(ssq, 16); ssq += __shfl_xor(ssq, 32);
            LAS float* SS = (LAS float*)(lds + SSOFF);
            if (g == 0) SS[vh * 64 + tb * 16 + tl] = ssq;
            __syncthreads();
            const float tot = SS[tb * 16 + tl] + SS[64 + tb * 16 + tl];
            const float rs = rsqrtf(tot * (1.0f / 256.0f) + EPS_);
            __syncthreads();
#pragma unroll
            for (int nb = 0; nb < 8; ++nb) {
                const int v = h * 256 + vh * 128 + nb * 16 + 4 * g;
                const u32x2 ow = owv[nb];
                const f32x4 gm = *(const f32x4*)(p.in[7] + v);
                const float o0 = sigm(bflo(ow.x)) * oacc[nb][0] * rs * gm.x, o1 = sigm(bfhi(ow.x)) * oacc[nb][1] * rs * gm.y;
                const float o2 = sigm(bflo(ow.y)) * oacc[nb][2] * rs * gm.z, o3 = sigm(bfhi(ow.y)) * oacc[nb][3] * rs * gm.w;
                u32x2 ov; ov.x = pk_bf16(o0, o1); ov.y = pk_bf16(o2, o3);
                *(u32x2*)(y + (size_t)trow * D_ + 1024 + v) = ov;
            }
        }
    }
}

__device__ void phase_act(const Params& p, const int wv) {
    const bf16_t* up = (const bf16_t*)(p.ws + WS_UP);
    bf16_t* act = (bf16_t*)(p.ws + WS_ACT);
    const float* cw = p.in[11]; const float* cb = p.in[12];
    constexpr int NCH = DFF_ / 8;
    for (int it = blockIdx.x * 512 + TID_X; it < (T_ / 8) * NCH; it += gridDim.x * 512) {
        const int cc = it % NCH, run = it / NCH, c = cc * 8, t0 = run * 8;
        const bool first = (t0 & (SEQ_ - 1)) == 0;
        u32x4 gr[10], ur[10];
#pragma unroll
        for (int d = 0; d < 10; ++d) {
            const int t = (first && d < 2) ? t0 : t0 + d - 2;
            gr[d] = __builtin_nontemporal_load((const u32x4*)(up + (size_t)t * NUP_ + c)); ur[d] = __builtin_nontemporal_load((const u32x4*)(up + (size_t)t * NUP_ + DFF_ + c));
        }
        f32x4 wgv[4][2], wuv[4][2];
#pragma unroll
        for (int k = 0; k < 3; ++k)
#pragma unroll
            for (int hh = 0; hh < 2; ++hh) { wgv[k][hh] = *(const f32x4*)(cw + k * NUP_ + c + 4 * hh); wuv[k][hh] = *(const f32x4*)(cw + k * NUP_ + DFF_ + c + 4 * hh); }
#pragma unroll
        for (int hh = 0; hh < 2; ++hh) { wgv[3][hh] = *(const f32x4*)(cb + c + 4 * hh); wuv[3][hh] = *(const f32x4*)(cb + DFF_ + c + 4 * hh); }
        SCHED_FENCE();
        float g2[8], g1[8], u2[8], u1[8];
        unpack8(gr[0], g2); unpack8(ur[0], u2); unpack8(gr[1], g1); unpack8(ur[1], u1);
        if (first) {
#pragma unroll
            for (int j = 0; j < 8; ++j) { g2[j] = 0.f; g1[j] = 0.f; u2[j] = 0.f; u1[j] = 0.f; }
        }
#pragma unroll
        for (int dt = 0; dt < 8; ++dt) {
            float g0[8], u0[8], o[8];
            unpack8(gr[dt + 2], g0); unpack8(ur[dt + 2], u0);
#pragma unroll
            for (int j = 0; j < 8; ++j) {
                const float G = wgv[0][j >> 2][j & 3] * g2[j] + wgv[1][j >> 2][j & 3] * g1[j] + wgv[2][j >> 2][j & 3] * g0[j] + wgv[3][j >> 2][j & 3];
                const float U = wuv[0][j >> 2][j & 3] * u2[j] + wuv[1][j >> 2][j & 3] * u1[j] + wuv[2][j >> 2][j & 3] * u0[j] + wuv[3][j >> 2][j & 3];
                o[j] = G * sigm(G) * U;
                g2[j] = g1[j]; g1[j] = g0[j]; u2[j] = u1[j]; u1[j] = u0[j];
            }
            *(u32x4*)(act + (size_t)(t0 + dt) * DFF_ + c) = pack8(o);
        }
    }
}

__device__ void phase_final(const Params& p, const int wv) {
    const int wid = wv, lane = lane_id();
    const float* ss = (const float*)(p.ws + WS_SMALL + SM_SSA);
    const bf16_t* x3b = (const bf16_t*)(p.ws + WS_X3B);
    const float* gf = p.in[17];
    f32x4 g0[4], g1[4];
#pragma unroll
    for (int i = 0; i < 4; ++i) { const int k = (i * 64 + lane) * 8; g0[i] = *(const f32x4*)(gf + k); g1[i] = *(const f32x4*)(gf + k + 4); }
    for (int rb = (blockIdx.x * 8 + wid) * 4; rb < T_; rb += gridDim.x * 8 * 4) {
        float sp[4]; u32x4 w[4][4];
#pragma unroll
        for (int r = 0; r < 4; ++r) {
            sp[r] = (lane < 32) ? ss[(size_t)(rb + r) * 32 + lane] : 0.f;
#pragma unroll
            for (int i = 0; i < 4; ++i) w[r][i] = *(const u32x4*)(x3b + (size_t)(rb + r) * D_ + (i * 64 + lane) * 8);
        }
#pragma unroll
        for (int r = 0; r < 4; ++r) {
            const float rs = rsqrtf(wave_sum(sp[r]) * (1.0f / D_) + EPS_);
            float* xr = p.out + (size_t)(rb + r) * D_;
#pragma unroll
            for (int i = 0; i < 4; ++i) {
                const int k = (i * 64 + lane) * 8;
                float f[8]; unpack8(w[r][i], f);
                *(f32x4*)(xr + k) = (f32x4){f[0], f[1], f[2], f[3]} * rs * g0[i];
                *(f32x4*)(xr + k + 4) = (f32x4){f[4], f[5], f[6], f[7]} * rs * g1[i];
            }
        }
    }
}

__device__ __forceinline__ unsigned xcc_id() { return (unsigned)__builtin_amdgcn_s_getreg((3 << 11) | 20) & 7u; }
__device__ __forceinline__ void grid_barrier(unsigned* bar, const unsigned k, const int wv) {
    asm volatile("s_waitcnt vmcnt(0) lgkmcnt(0)" ::: "memory");
    __builtin_amdgcn_s_barrier();
    if (wv == 0) {
        const unsigned x = xcc_id();
        unsigned last = 0;
        if (lane_id() == 0) {
            if (k == 1u) {
                for (;;) { unsigned tot = 0;
                    for (int j = 0; j < 8; ++j) tot += __hip_atomic_load(bar + 64 * (9 + j), __ATOMIC_RELAXED, __HIP_MEMORY_SCOPE_AGENT);
                    if (tot >= gridDim.x) break; __builtin_amdgcn_s_sleep(1); } }
            const unsigned n = __hip_atomic_load(bar + 64 * (9 + x), __ATOMIC_RELAXED, __HIP_MEMORY_SCOPE_AGENT);
            const unsigned old = __hip_atomic_fetch_add(bar + 64 * (1 + x), 1u, __ATOMIC_RELAXED, __HIP_MEMORY_SCOPE_AGENT);
            last = (old + 1u == n * k) ? 1u : 0u;
        }
        last = (unsigned)__builtin_amdgcn_readfirstlane((int)last);
        if (last) {
            __builtin_amdgcn_fence(__ATOMIC_RELEASE, "agent");
            asm volatile("s_waitcnt vmcnt(0)" ::: "memory");
            if (lane_id() == 0) __hip_atomic_fetch_add(bar, 1u, __ATOMIC_RELAXED, __HIP_MEMORY_SCOPE_AGENT);
        }
        if (lane_id() == 0) {
            unsigned nx = 0;
            for (int j = 0; j < 8; ++j) nx += __hip_atomic_load(bar + 64 * (9 + j), __ATOMIC_RELAXED, __HIP_MEMORY_SCOPE_AGENT) ? 1u : 0u;
            while (__hip_atomic_load(bar, __ATOMIC_RELAXED, __HIP_MEMORY_SCOPE_AGENT) < nx * k) __builtin_amdgcn_s_sleep(1);
        }
        __builtin_amdgcn_fence(__ATOMIC_ACQUIRE, "agent");
        asm volatile("s_waitcnt vmcnt(0)" ::: "memory");
    }
    __builtin_amdgcn_s_barrier();
}

constexpr int N_PHASES = 8;
__global__ void __launch_bounds__(512, 2) fwd_kernel(Params p) {
    extern __shared__ __attribute__((aligned(16))) unsigned char lds_raw[];
    LAS unsigned char* lds = (LAS unsigned char*)lds_raw;
    unsigned char* ws = p.ws;
    pg8::StaticOrder S;
    const int wv = __builtin_amdgcn_readfirstlane((int)(threadIdx.x >> 6));
    unsigned* const gbar = (unsigned*)(ws + WS_SMALL + SM_BAR);
    unsigned nbar = 0;
#define PHASE_BEGIN(n) if (p.ph_lo <= (n) && (n) < p.ph_hi) {
#define PHASE_END(n) if ((n) + 1 < p.ph_hi) { ++nbar; grid_barrier(gbar, nbar, wv); } }
#define PHASE_END_CG(n) if ((n) + 1 < p.ph_hi) cg::this_grid().sync(); }
    if (p.ph_lo == 0 && p.ph_hi > 1) {
        if (blockIdx.x == 0 && threadIdx.x < 17) __hip_atomic_store(gbar + 64 * threadIdx.x, 0u, __ATOMIC_RELAXED, __HIP_MEMORY_SCOPE_AGENT);
        if (blockIdx.x == 1 && threadIdx.x < 32) __hip_atomic_store((unsigned*)(ws + WS_SMALL + SM_CNT) + 64 * threadIdx.x, 0u, __ATOMIC_RELAXED, __HIP_MEMORY_SCOPE_AGENT);
        cg::this_grid().sync();
        if (wv == 0 && lane_id() == 0) __hip_atomic_fetch_add(gbar + 64 * (9 + xcc_id()), 1u, __ATOMIC_RELAXED, __HIP_MEMORY_SCOPE_AGENT);
    }
    PHASE_BEGIN(0)
        phase_prep(p, lds, wv);
    PHASE_END(0)
    PHASE_BEGIN(1)
        if (wv == 0) for (int bh = blockIdx.x; bh < 16; bh += gridDim.x)
            scan_gates((const float*)(ws + WS_SMALL + SM_GATES), (float*)(ws + WS_SMALL + SM_ACUM), (float*)(ws + WS_SMALL + SM_MRUN), (float*)(ws + WS_SMALL + SM_BCUM), bh, lane_id());
        { pg8::Gemm g{(const bf16_t*)(ws + WS_XB), (const bf16_t*)(ws + WS_WIN), T_, NP_, D_}; S.init(T_, NP_, gridDim.x, blockIdx.x);
          EpiBf16Scale E{(bf16_t*)(ws + WS_PROJ), NP_, (const float*)(ws + WS_SMALL + SM_RSTD0)}; pg8::gemm_phase(lds, g, S, E, wv); }
    PHASE_END(1)
    PHASE_BEGIN(2)
        phase_convgroup(p, wv);
        phase_mlstm(p, lds, wv);
    PHASE_END(2)
    PHASE_BEGIN(3)
        { pg8::Gemm g{(const bf16_t*)(ws + WS_Y), (const bf16_t*)(ws + WS_WOUT), T_, D_, D_}; S.init(T_, D_, gridDim.x, blockIdx.x);
          EpiResidBf E{(const bf16_t*)(ws + WS_XB), (bf16_t*)p.out, (float*)(ws + WS_SMALL + SM_SSA)}; pg8::gemm_phase(lds, g, S, E, wv); }
    PHASE_END(3)
    PHASE_BEGIN(4)
        { pg8::Gemm g{(const bf16_t*)p.out, (const bf16_t*)(ws + WS_WUP), T_, NUP_, D_}; S.init(T_, NUP_, gridDim.x, blockIdx.x);
          EpiBf16Norm E{(bf16_t*)(ws + WS_UP), NUP_, (const float*)(ws + WS_SMALL + SM_SSA)}; pg8::gemm_phase(lds, g, S, E, wv); }
        { const int nunits = (T_ / 256) * (NUP_ / 256), nfull = nunits % (int)gridDim.x;
          const int worker = nfull ? (int)blockIdx.x - nfull : (int)blockIdx.x, nworkers = nfull ? (int)gridDim.x - nfull : (int)gridDim.x;
          if (worker >= 0) {
              convert_tiles(p, lds, NT_EARLY, NT_ALL, worker, nworkers, wv);
              __syncthreads();
              pg8::Gemm g2{(const bf16_t*)p.out + OUT_PB, (const bf16_t*)p.out + OUT_WPP, T_, D_, DPLE_}; S.init(T_, D_, nworkers, worker);
              EpiBf16Scale E2{(bf16_t*)(ws + WS_PP), D_, nullptr}; pg8::gemm_phase(lds, g2, S, E2, wv); } }
    PHASE_END(4)
    PHASE_BEGIN(5)
        phase_act(p, wv);
    PHASE_END(5)
    PHASE_BEGIN(6)
        { pg8::Gemm g{(const bf16_t*)(ws + WS_ACT), (const bf16_t*)(ws + WS_WDOWN), T_, D_, DFF_}; S.init(T_, D_, gridDim.x, blockIdx.x);
          EpiResidBf E{(const bf16_t*)p.out, (bf16_t*)(ws + WS_X2B2), (float*)(ws + WS_SMALL + SM_SSB)}; pg8::gemm_phase(lds, g, S, E, wv); }
    PHASE_END(6)
    PHASE_BEGIN(7)
        { pg8::Gemm g{(const bf16_t*)(ws + WS_X2B2), (const bf16_t*)(ws + WS_WPG), T_, D_, D_}; S.init(T_, D_, gridDim.x, blockIdx.x);
          EpiPleFinal E{(const bf16_t*)(ws + WS_X2B2), (const bf16_t*)(ws + WS_PP), (const float*)(ws + WS_SMALL + SM_SSB), (float*)(ws + WS_SMALL + SM_SSA),
                        (unsigned*)(ws + WS_SMALL + SM_CNT), p.in[17], p.out}; pg8::gemm_phase(lds, g, S, E, wv); }
    PHASE_END(7)
}

extern "C" void kernel_launch(void* const* d_in, const int* in_sizes, int n_in, void* d_out, int out_size, void* d_ws, size_t ws_size, hipStream_t stream) {
    static int grid = 0;
    if (grid == 0) {
        if (n_in != 18 || out_size != T_ * D_ || ws_size < WS_END) { fprintf(stderr, "kernel_launch: unexpected shapes: n_in %d out %d ws %zu (need %zu)\n", n_in, out_size, ws_size, (size_t)WS_END); grid = -1; return; }
        int dev = 0, cus = 0, per_cu = 0;
        hipGetDevice(&dev);
        hipDeviceGetAttribute(&cus, hipDeviceAttributeMultiprocessorCount, dev);
        if (hipFuncSetAttribute((const void*)fwd_kernel, hipFuncAttributeMaxDynamicSharedMemorySize, LDS_BYTES) != hipSuccess) { fprintf(stderr, "kernel_launch: hipFuncSetAttribute failed\n"); grid = -1; return; }
        if (hipOccupancyMaxActiveBlocksPerMultiprocessor(&per_cu, (const void*)fwd_kernel, 512, LDS_BYTES) != hipSuccess || per_cu < 1) { fprintf(stderr, "kernel_launch: occupancy query says %d\n", per_cu); per_cu = 1; (void)hipGetLastError(); }
        grid = cus * per_cu;
        if (grid > 256) grid = 256;
        fprintf(stderr, "kernel_launch: grid %d (cus %d x %d), ws %zu\n", grid, cus, per_cu, ws_size);
    }
    if (grid < 0) return;
    Params prm{};
    for (int i = 0; i < 18; ++i) prm.in[i] = (const float*)d_in[i];
    prm.out = (float*)d_out; prm.ws = (unsigned char*)d_ws;
#if N_LAUNCH_MODE == 1
    prm.ph_lo = 0; prm.ph_hi = N_PHASES;
    void* args[] = {&prm};
    hipError_t e = hipLaunchCooperativeKernel((const void*)fwd_kernel, dim3(grid), dim3(512), args, LDS_BYTES, stream);
    if (e != hipSuccess) fprintf(stderr, "kernel_launch: cooperative launch failed: %s (grid %d)\n", hipGetErrorString(e), grid);
#else
    for (int ph = 0; ph < N_PHASES; ++ph) {
        prm.ph_lo = ph; prm.ph_hi = ph + 1;
        hipLaunchKernelGGL(fwd_kernel, dim3(grid), dim3(512), LDS_BYTES, stream, prm);
    }
#endif
}
```
